# Optimizing an MI355X kernel written in HIP

```python
import jax, jax.numpy as jnp
from jax import lax
import numpy as np

D_MODEL = 2048
BATCH = 4
SEQ = 2048
DEPTH = 1
DEC_BATCH = 32
DEC_SEQ = 1
PAST_LEN = 8192
PAGE_SIZE = 128

HEAD_DIM = 128
N_HEADS_ATTN = 6
N_HEADS_HGRN = 6
N_HEADS_MEM = 4
W_ATTN = N_HEADS_ATTN * HEAD_DIM
W_HGRN = N_HEADS_HGRN * HEAD_DIM
W_MEM = N_HEADS_MEM * HEAD_DIM
MIX_WIDTH = W_ATTN + W_HGRN + W_MEM
HGRN_EXPAND = HEAD_DIM
WINDOWS = (128, 512, 2048)
DILATIONS = (1, 4, 16)
MAX_WINDOW = max(WINDOWS)
N_MEM = 256
ROPE_THETA = 10000.0
HGRN_CHUNK = 64
LN_EPS = 1e-5
RMS_EPS = 1e-6
NEG_INF = -1e30
DEEPNORM_ALPHA = (2 * DEPTH) ** 0.25
DEEPNORM_BETA = (8 * DEPTH) ** -0.25
IN_WIDTHS = (W_ATTN,) * 4 + (W_HGRN,) * 4 + (W_MEM,) * 2
IN_PROJ = sum(IN_WIDTHS)

kernel_name = 'dilated_hgrn2_memory_hybrid_step'

F32 = jnp.float32


def _heads(a):
    return a.reshape(a.shape[:-1] + (-1, HEAD_DIM))


def _split_cols(proj):
    offsets = np.cumsum(IN_WIDTHS)[:-1].tolist()
    return jnp.split(proj, offsets, axis=-1)


def _rope(x, pos):
    half = HEAD_DIM // 2
    inv_freq = 1.0 / (ROPE_THETA ** (jnp.arange(half, dtype=F32) / half))
    ang = pos.astype(F32)[:, None] * inv_freq[None, :]
    cos = jnp.cos(ang)[None, :, None, :]
    sin = jnp.sin(ang)[None, :, None, :]
    xf = x.astype(F32)
    x1, x2 = xf[..., :half], xf[..., half:]
    return jnp.concatenate([x1 * cos - x2 * sin, x2 * cos + x1 * sin], axis=-1).astype(x.dtype)


def _dilated_prompt(q, k, v, window, dil):
    bsz, seq, nh, hd = q.shape
    blk = window // dil
    unit = dil * blk
    s_pad = -(-seq // unit) * unit
    m_len = s_pad // dil
    nb = m_len // blk
    pad = ((0, 0), (0, s_pad - seq), (0, 0), (0, 0))

    def to_blocks(a):
        a = jnp.pad(a.astype(F32), pad).reshape(bsz, m_len, dil, nh, hd)
        return a.transpose(0, 2, 3, 1, 4).reshape(bsz, dil, nh, nb, blk, hd)

    def with_prev(a):
        prev = jnp.pad(a, ((0, 0), (0, 0), (0, 0), (1, 0), (0, 0), (0, 0)))[:, :, :, :-1]
        return jnp.concatenate([prev, a], axis=4)

    qb = to_blocks(q)
    kb = with_prev(to_blocks(k))
    vb = with_prev(to_blocks(v))
    s = jnp.einsum('brhnqd,brhnkd->brhnqk', qb, kb) * hd ** -0.5
    qi = jnp.arange(blk)[:, None]
    ki = jnp.arange(2 * blk)[None, :]
    dist = qi + blk - ki
    band = (dist >= 0) & (dist <= blk)
    valid = band[None] & ((jnp.arange(nb)[:, None, None] > 0) | (ki[None] >= blk))
    s = jnp.where(valid, s, NEG_INF)
    m = jnp.max(s, axis=-1, keepdims=True)
    p = jnp.exp(s - m)
    den = jnp.sum(p, axis=-1)
    o = jnp.einsum('brhnqk,brhnkd->brhnqd', p, vb) / den[..., None]
    lse = m[..., 0] + jnp.log(den)
    o = o.reshape(bsz, dil, nh, m_len, hd).transpose(0, 3, 1, 2, 4).reshape(bsz, s_pad, nh, hd)[:, :seq]
    lse = lse.reshape(bsz, dil, nh, m_len).transpose(0, 3, 1, 2).reshape(bsz, s_pad, nh)[:, :seq]
    return o, lse


def _dilated_sample(q, k_all, v_all, window, dil):
    n_new = q.shape[1]
    past = k_all.shape[1] - n_new
    steps = window // dil
    idx = (past + jnp.arange(n_new))[:, None] - dil * jnp.arange(steps + 1)[None, :]
    valid = idx >= 0
    idx = jnp.maximum(idx, 0)
    kg = k_all[:, idx].astype(F32)
    vg = v_all[:, idx].astype(F32)
    s = jnp.einsum('blhd,blnhd->blhn', q.astype(F32), kg) * q.shape[-1] ** -0.5
    s = jnp.where(valid[None, :, None, :], s, NEG_INF)
    m = jnp.max(s, axis=-1, keepdims=True)
    p = jnp.exp(s - m)
    den = jnp.sum(p, axis=-1)
    o = jnp.einsum('blhn,blnhd->blhd', p, vg) / den[..., None]
    return o, m[..., 0] + jnp.log(den)


def _combine_dilations(outs, lses):
    wts = jax.nn.softmax(jnp.stack(lses), axis=0)
    return jnp.sum(wts[..., None] * jnp.stack(outs), axis=0)


def _hgrn_inputs(qb, fb, ib, lb):
    f = lb + (1.0 - lb) * jax.nn.sigmoid(fb.astype(F32))
    return (_heads(qb.astype(F32)), _heads(1.0 - f), _heads(ib.astype(F32)), _heads(jnp.log(f)))


def _hgrn_chunked(q, k, v, log_f, s0):
    bsz, n_tok, nh, kd = q.shape
    vd = v.shape[-1]
    c = min(HGRN_CHUNK, n_tok)
    n_chunks = -(-n_tok // c)
    l_pad = n_chunks * c
    pad = ((0, 0), (0, l_pad - n_tok), (0, 0), (0, 0))

    def chunks(a):
        a = jnp.pad(a, pad).reshape(bsz, n_chunks, c, nh, a.shape[-1])
        return a.transpose(1, 0, 3, 2, 4)

    tri = jnp.tril(jnp.ones((c, c), dtype=bool))

    def step(state, inp):
        qc, kc, vc, gc = inp
        b = jnp.cumsum(gc, axis=2)
        rel = b[:, :, :, None, :] - b[:, :, None, :, :]
        decay = jnp.where(tri[None, None, :, :, None], jnp.exp(jnp.minimum(rel, 0.0)), 0.0)
        att = jnp.einsum('bhtk,bhsk,bhtsk->bhts', qc, kc, decay)
        o = jnp.einsum('bhts,bhsv->bhtv', att, vc) + jnp.einsum('bhtk,bhkv->bhtv', qc * jnp.exp(b), state)
        b_last = b[:, :, -1, :]
        new_state = jnp.exp(b_last)[..., None] * state + jnp.einsum(
            'bhsk,bhsv->bhkv', kc * jnp.exp(b_last[:, :, None, :] - b), vc)
        return new_state, o

    s_fin, o = lax.scan(step, s0, (chunks(q), chunks(k), chunks(v), chunks(log_f)))
    o = o.transpose(1, 0, 3, 2, 4).reshape(bsz, l_pad, nh, vd)[:, :n_tok]
    return o, s_fin


def _mem_attend(q, mk, mv):
    s = jnp.einsum('blhd,bmhd->bhlm', q.astype(F32), mk.astype(F32)) * HEAD_DIM ** -0.5
    p = jax.nn.softmax(s, axis=-1)
    return jnp.einsum('bhlm,bmhd->blhd', p, mv.astype(F32))


def _merge(x, o_attn, ga, o_hgrn, gb, o_mem, gm, norm_g, w_out, ln_g, ln_b):
    bsz, n_tok = x.shape[:2]
    o_h = o_hgrn * lax.rsqrt(jnp.mean(o_hgrn * o_hgrn, axis=-1, keepdims=True) + RMS_EPS)
    o_h = o_h.reshape(bsz, n_tok, W_HGRN) * norm_g.astype(F32)
    z = jnp.concatenate([
        o_attn.reshape(bsz, n_tok, W_ATTN) * jax.nn.silu(ga.astype(F32)),
        o_h * jax.nn.silu(gb.astype(F32)),
        o_mem.reshape(bsz, n_tok, W_MEM) * jax.nn.silu(gm.astype(F32)),
    ], axis=-1).astype(x.dtype)
    y = z @ w_out
    r = DEEPNORM_ALPHA * x.astype(F32) + y.astype(F32)
    mu = jnp.mean(r, axis=-1, keepdims=True)
    var = jnp.mean((r - mu) ** 2, axis=-1, keepdims=True)
    out = (r - mu) * lax.rsqrt(var + LN_EPS) * ln_g.astype(F32) + ln_b.astype(F32)
    return out.astype(x.dtype)


def _prompt_layer(x, mem, w_in, w_mem_kv, lb, norm_g, w_out, ln_g, ln_b):
    bsz, seq, _ = x.shape
    pos = jnp.arange(seq)
    qa, ka, va, ga, qb, fb, ib, gb, qm, gm = _split_cols(x @ w_in)
    qa, ka, va = _rope(_heads(qa), pos), _rope(_heads(ka), pos), _heads(va)
    branches = [_dilated_prompt(qa, ka, va, w, d) for w, d in zip(WINDOWS, DILATIONS)]
    o_attn = _combine_dilations([br[0] for br in branches], [br[1] for br in branches])
    qh, kh, vh, logf = _hgrn_inputs(qb, fb, ib, lb)
    s0 = jnp.zeros((bsz, N_HEADS_HGRN, HGRN_EXPAND, HEAD_DIM), F32)
    o_hgrn, s_fin = _hgrn_chunked(qh, kh, vh, logf, s0)
    mk, mv = jnp.split(mem @ w_mem_kv, 2, axis=-1)
    mk, mv = _heads(mk), _heads(mv)
    o_mem = _mem_attend(_heads(qm), mk, mv)
    y = _merge(x, o_attn, ga, o_hgrn, gb, o_mem, gm, norm_g, w_out, ln_g, ln_b)
    keep = min(MAX_WINDOW, seq)
    return y, ka[:, seq - keep:], va[:, seq - keep:], s_fin, mk, mv


def _sample_layer(x, win_k, win_v, s_prev, mem_k, mem_v, w_in, lb, norm_g, w_out, ln_g, ln_b):
    n_new = x.shape[1]
    pos = PAST_LEN + jnp.arange(n_new)
    qa, ka, va, ga, qb, fb, ib, gb, qm, gm = _split_cols(x @ w_in)
    qa, ka, va = _rope(_heads(qa), pos), _rope(_heads(ka), pos), _heads(va)
    k_all = jnp.concatenate([win_k.astype(ka.dtype), ka], axis=1)
    v_all = jnp.concatenate([win_v.astype(va.dtype), va], axis=1)
    branches = [_dilated_sample(qa, k_all, v_all, w, d) for w, d in zip(WINDOWS, DILATIONS)]
    o_attn = _combine_dilations([br[0] for br in branches], [br[1] for br in branches])
    qh, kh, vh, logf = _hgrn_inputs(qb, fb, ib, lb)
    o_hgrn, s_new = _hgrn_chunked(qh, kh, vh, logf, s_prev.astype(F32))
    o_mem = _mem_attend(_heads(qm), mem_k, mem_v)
    y = _merge(x, o_attn, ga, o_hgrn, gb, o_mem, gm, norm_g, w_out, ln_g, ln_b)
    return y, ka, va, s_new.astype(s_prev.dtype)


def setup_inputs(seed: int = 0) -> dict:
    key = jax.random.key(seed)
    ks = jax.random.split(key, 16)
    w_buf = min(MAX_WINDOW, PAST_LEN)
    nrm = jax.random.normal
    return {
        'x_prompt': nrm(ks[0], (BATCH, SEQ, D_MODEL), F32),
        'x_sample': nrm(ks[1], (DEC_BATCH, DEC_SEQ, D_MODEL), F32),
        'cache_win_k': nrm(ks[2], (DEPTH, DEC_BATCH, w_buf, N_HEADS_ATTN, HEAD_DIM), F32),
        'cache_win_v': nrm(ks[3], (DEPTH, DEC_BATCH, w_buf, N_HEADS_ATTN, HEAD_DIM), F32),
        'state_hgrn': 0.5 * nrm(ks[4], (DEPTH, DEC_BATCH, N_HEADS_HGRN, HGRN_EXPAND, HEAD_DIM), F32),
        'cache_mem_k': nrm(ks[5], (DEPTH, DEC_BATCH, N_MEM, N_HEADS_MEM, HEAD_DIM), F32),
        'cache_mem_v': nrm(ks[6], (DEPTH, DEC_BATCH, N_MEM, N_HEADS_MEM, HEAD_DIM), F32),
        'mem_prompt': nrm(ks[7], (BATCH, N_MEM, D_MODEL), F32),
        'w_in': nrm(ks[8], (DEPTH, D_MODEL, IN_PROJ), F32) * D_MODEL ** -0.5,
        'w_mem_kv': nrm(ks[9], (DEPTH, D_MODEL, 2 * W_MEM), F32) * D_MODEL ** -0.5,
        'hgrn_lb_raw': 0.1 * nrm(ks[10], (DEPTH + 1, W_HGRN), F32),
        'hgrn_norm_g': 1.0 + 0.02 * nrm(ks[11], (DEPTH, W_HGRN), F32),
        'w_out': nrm(ks[12], (DEPTH, MIX_WIDTH, D_MODEL), F32) * (MIX_WIDTH ** -0.5 * DEEPNORM_BETA),
        'ln_g': 1.0 + 0.02 * nrm(ks[13], (DEPTH, D_MODEL), F32),
        'ln_b': 0.02 * nrm(ks[14], (DEPTH, D_MODEL), F32),
    }


def reference(x_prompt, x_sample, cache_win_k, cache_win_v, state_hgrn, cache_mem_k, cache_mem_v,
              mem_prompt, w_in, w_mem_kv, hgrn_lb_raw, hgrn_norm_g, w_out, ln_g, ln_b):
    lb_all = jnp.cumsum(jax.nn.softmax(hgrn_lb_raw.astype(F32), axis=0), axis=0)
    hp, hs = x_prompt, x_sample
    pk, pv, ps, pmk, pmv, sk, sv, ss = [], [], [], [], [], [], [], []
    for layer in range(DEPTH):
        hp, k1, v1, s1, mk1, mv1 = _prompt_layer(
            hp, mem_prompt, w_in[layer], w_mem_kv[layer], lb_all[layer], hgrn_norm_g[layer],
            w_out[layer], ln_g[layer], ln_b[layer])
        hs, k2, v2, s2 = _sample_layer(
            hs, cache_win_k[layer], cache_win_v[layer], state_hgrn[layer], cache_mem_k[layer],
            cache_mem_v[layer], w_in[layer], lb_all[layer], hgrn_norm_g[layer], w_out[layer],
            ln_g[layer], ln_b[layer])
        pk.append(k1); pv.append(v1); ps.append(s1); pmk.append(mk1); pmv.append(mv1)
        sk.append(k2); sv.append(v2); ss.append(s2)
    return (hp, hs, jnp.stack(pk), jnp.stack(pv), jnp.stack(ps), jnp.stack(pmk), jnp.stack(pmv),
            jnp.stack(sk), jnp.stack(sv), jnp.stack(ss))
```

```cpp
#include <hip/hip_runtime.h>
#include <cstdio>
#include <cstdint>
#include <hip/hip_runtime.h>
#include <cstdio>
#include <cstdint>
namespace pg8 {
#define PG8_LAS __attribute__((address_space(3)))
typedef unsigned short bf16_t;
typedef short bf16x8 __attribute__((ext_vector_type(8)));
typedef float f32x4 __attribute__((ext_vector_type(4)));
typedef unsigned u32x4 __attribute__((ext_vector_type(4)));
constexpr int BM = 256, BK = 64, HALF = 128, HTB = HALF * BK * 2  , STAGE_BYTES = 8 * HTB, NXCD = 8, WGM = 8;

__host__ __device__ __forceinline__ int lds_byte(int r, int c) { const int st = (r >> 4) * 2 + (c >> 5), rr = r & 15, cc = c & 31, ob = rr * 64 + cc * 2; return st * 1024 + (ob ^ (((ob >> 9) & 1) << 5)); }
__host__ __device__ __forceinline__ void stage_rc(int b, int& R, int& C) { const int st = b / 1024, sb = b % 1024, swz = sb ^ (((sb >> 9) & 1) << 5); R = (st >> 1) * 16 + swz / 64; C = (st & 1) * 32 + (swz % 64) / 2; }
__host__ __device__ __forceinline__ int perm32(int rho) { const int n = rho >> 4, i = rho & 15; return 8 * (i >> 2) + 4 * n + (i & 3); }

struct Unit { int pm, pn; };
struct Gemm { const bf16_t* A; const bf16_t* Bt; int M, N, K; };

struct StaticOrder {
    int nM, nN, nwg, G, c;
    __host__ __device__ void init(int M, int N, int G_, int c_) { nM = M / BM; nN = N / BM; nwg = nM * nN; G = G_; c = c_; }
    __host__ __device__ bool next(int i, Unit& u) const {
        const long L = (long)i * G + c; if (L >= nwg) return false;
        int wgid = (int)L; { const int q = nwg / NXCD, r = nwg % NXCD, xcd = wgid % NXCD, off = wgid / NXCD; wgid = (xcd < r ? xcd * (q + 1) : r * (q + 1) + (xcd - r) * q) + off; }
        const int nig = WGM * nN, gid = wgid / nig, fm = gid * WGM, gsz = (nM - fm) < WGM ? (nM - fm) : WGM;
        u.pm = fm + ((wgid % nig) % gsz); u.pn = (wgid % nig) / gsz; return true;
    }
    __device__ __forceinline__ void a_ready(const Unit&) const {}
    __device__ __forceinline__ void done(const Unit&) const {}
};

__device__ __forceinline__ unsigned cvt_pk_bf16(float lo, float hi) { unsigned r; asm volatile("v_cvt_pk_bf16_f32 %0, %1, %2" : "=v"(r) : "v"(lo), "v"(hi)); return r; }
typedef float f32x2 __attribute__((ext_vector_type(2)));
__device__ __forceinline__ f32x2 gelu_pk(f32x2 v) {
    const f32x2 av = __builtin_elementwise_abs(v), d = av * 0.2316418882f + 1.0f;
    f32x2 t; t.x = __builtin_amdgcn_rcpf(d.x); t.y = __builtin_amdgcn_rcpf(d.y);
    f32x2 q = t * 0.5307027145f + (-0.7265760135f); q = q * t + 0.7107068705f; q = q * t + (-0.142248368f); q = q * t + 0.127414796f; q = q * t;
    const f32x2 s = (v * v) * (-0.72134752044f);
    f32x2 e; e.x = __builtin_amdgcn_exp2f(s.x); e.y = __builtin_amdgcn_exp2f(s.y);
    const f32x2 m = v * (q * e), r = v - m;
    f32x2 o; o.x = v.x < 0.f ? m.x : r.x; o.y = v.y < 0.f ? m.y : r.y; return o;
}

template <int ACT  > struct EpiBf16 {
    static constexpr bool PERM = true, AFTER_DRAIN = false; static_assert(ACT == 0 || ACT == 1, "EpiBf16: ACT is 0 (none) or 1 (gelu_pk)");
    bf16_t* O; int ldc; const float* bias; int split_cols; size_t split_stride; float scale0;
    __device__ __forceinline__ void operator()(const f32x4 (&acc)[2][2][4][2], const Unit& u, int wr, int wc, int fr, int fq) const {
        const int row0 = u.pm * BM + wr * 64 + fr; int colt = u.pn * BM; bf16_t* base = O;
        float sc = 1.f; if (split_cols) { const int t = colt / split_cols; base += (size_t)t * split_stride; colt -= t * split_cols; if (t == 0) sc = scale0; }
        const int col0 = colt + wc * 32 + 8 * fq, bcol0 = u.pn * BM + wc * 32 + 8 * fq;
        f32x4 bv[2][2];
#pragma unroll
        for (int bj = 0; bj < 2; ++bj)
#pragma unroll
            for (int n = 0; n < 2; ++n) bv[bj][n] = bias ? *(const f32x4*)(bias + bcol0 + bj * HALF + 4 * n) : (f32x4){0.f, 0.f, 0.f, 0.f};
#pragma unroll
        for (int ai = 0; ai < 2; ++ai)
#pragma unroll
            for (int m = 0; m < 4; ++m) { bf16_t* rowp = base + (size_t)(row0 + ai * HALF + m * 16) * ldc + col0;
#pragma unroll
                for (int bj = 0; bj < 2; ++bj) { f32x4 v0 = acc[ai][bj][m][0] + bv[bj][0], v1 = acc[ai][bj][m][1] + bv[bj][1];
                    if (ACT == 1) { f32x2 a = gelu_pk((f32x2){v0[0], v0[1]}), b = gelu_pk((f32x2){v0[2], v0[3]}), c = gelu_pk((f32x2){v1[0], v1[1]}), d = gelu_pk((f32x2){v1[2], v1[3]});
                        v0 = (f32x4){a.x, a.y, b.x, b.y}; v1 = (f32x4){c.x, c.y, d.x, d.y}; }
                    v0 = v0 * sc; v1 = v1 * sc; u32x4 w; w.x = cvt_pk_bf16(v0[0], v0[1]); w.y = cvt_pk_bf16(v0[2], v0[3]); w.z = cvt_pk_bf16(v1[0], v1[1]); w.w = cvt_pk_bf16(v1[2], v1[3]);
                    *(u32x4*)(rowp + bj * HALF) = w; } }
    }
};

struct PanelStats {
    unsigned* xbuf;
    unsigned* cnt;
    unsigned* tmo;
    int ntn; float eps;
    unsigned code;
    __device__ __forceinline__ bool run(const f32x4 (&v)[2][2][4][2], const Unit& u, int wr, int wc, int fr, int fq, PG8_LAS unsigned char* lds, int wid, int lane) const {
        typedef float f32x2v __attribute__((ext_vector_type(2)));
        PG8_LAS f32x2v* P = (PG8_LAS f32x2v*)lds;
        PG8_LAS f32x2v* S = (PG8_LAS f32x2v*)(lds + 8192);
        PG8_LAS unsigned* flag = (PG8_LAS unsigned*)(lds + 8192 + 2048);
#pragma unroll
        for (int ai = 0; ai < 2; ++ai)
#pragma unroll
            for (int m = 0; m < 4; ++m) {
                float s = 0.f;
#pragma unroll
                for (int bj = 0; bj < 2; ++bj)
#pragma unroll
                    for (int n = 0; n < 2; ++n) { const f32x4 x = v[ai][bj][m][n]; s += (x[0] + x[1]) + (x[2] + x[3]); }
                s += __shfl_xor(s, 16); s += __shfl_xor(s, 32);
                const float mw = s * (1.0f / 64.0f); float q = 0.f;
#pragma unroll
                for (int bj = 0; bj < 2; ++bj)
#pragma unroll
                    for (int n = 0; n < 2; ++n) { const f32x4 d = v[ai][bj][m][n] - mw; q += (d[0] * d[0] + d[1] * d[1]) + (d[2] * d[2] + d[3] * d[3]); }
                q += __shfl_xor(q, 16); q += __shfl_xor(q, 32);
                if (fq == 0) P[(ai * HALF + wr * 64 + m * 16 + fr) * 4 + wc] = (f32x2v){mw, q};
            }
        asm volatile("s_waitcnt lgkmcnt(0)" ::: "memory"); __builtin_amdgcn_s_barrier(); asm volatile("" ::: "memory");
#if defined(BROKEN_EXCHANGE_NO_WAIT)
#warning BROKEN CONTROL BUILD: the row-statistics exchange does not wait; results are wrong by design
        if (blockIdx.x >= 64) { const long long t0_ = clock64(); while (clock64() - t0_ < 60000) __builtin_amdgcn_s_sleep(8); }
#endif
        const int row = wid * 32 + (lane & 31);
        if (lane < 32) {
            const f32x2v a = P[row * 4 + 0], b = P[row * 4 + 1], c = P[row * 4 + 2], d = P[row * 4 + 3];
            const float mt = (a.x + b.x + c.x + d.x) * 0.25f;
            const float da = a.x - mt, db = b.x - mt, dc = c.x - mt, dd = d.x - mt;
            const float m2 = (a.y + b.y) + (c.y + d.y) + 64.0f * ((da * da + db * db) + (dc * dc + dd * dd));
            unsigned long long* slot = (unsigned long long*)xbuf + ((size_t)(u.pm * BM + row) * 4 + u.pn);
            __hip_atomic_store(slot, ((unsigned long long)__float_as_uint(m2) << 32) | __float_as_uint(mt), __ATOMIC_RELAXED, __HIP_MEMORY_SCOPE_AGENT);
        }
        asm volatile("s_waitcnt vmcnt(0)" ::: "memory");
        if (lane == 0) __hip_atomic_fetch_add(cnt + 64 * u.pm, 1u, __ATOMIC_RELAXED, __HIP_MEMORY_SCOPE_AGENT);
        if (wid == 0) {
            bool dead = false; const unsigned long long t0 = __builtin_amdgcn_s_memrealtime(); const unsigned want = 8u * (unsigned)ntn;
            for (;;) {
#if defined(BROKEN_EXCHANGE_NO_WAIT)
                break;
#endif
                if ((unsigned)__builtin_amdgcn_readfirstlane(__hip_atomic_load(cnt + 64 * u.pm, __ATOMIC_RELAXED, __HIP_MEMORY_SCOPE_AGENT)) >= want) break;
                if (__builtin_amdgcn_s_memrealtime() - t0 > 2000000ull) {
                    if (lane == 0) { unsigned expect = 0u; __hip_atomic_compare_exchange_strong(tmo + 1, &expect, code | (unsigned)(u.pm & 0xff), __ATOMIC_RELAXED, __ATOMIC_RELAXED, __HIP_MEMORY_SCOPE_AGENT);
                                     __hip_atomic_store(tmo, 1u, __ATOMIC_RELAXED, __HIP_MEMORY_SCOPE_AGENT); }
                    dead = true; break; }
                __builtin_amdgcn_s_sleep(2);
            }
            __builtin_amdgcn_fence(__ATOMIC_ACQUIRE, "agent");
            if (lane == 0) flag[0] = dead ? 1u : 0u;
        }
        asm volatile("s_waitcnt vmcnt(0) lgkmcnt(0)" ::: "memory"); __builtin_amdgcn_s_barrier(); asm volatile("" ::: "memory");
        const bool bad = flag[0] != 0u;
        if (lane < 32) {
            const unsigned long long* slot = (const unsigned long long*)xbuf + (size_t)(u.pm * BM + row) * 4; float mt[4], m2[4]; float ms = 0.f;
#pragma unroll
            for (int t = 0; t < 4; ++t) { if (t < ntn) { const unsigned long long w = __hip_atomic_load(slot + t, __ATOMIC_RELAXED, __HIP_MEMORY_SCOPE_AGENT); mt[t] = __uint_as_float((unsigned)w); m2[t] = __uint_as_float((unsigned)(w >> 32)); } else { mt[t] = 0.f; m2[t] = 0.f; } ms += mt[t]; }
            const float mean = ms / (float)ntn; float q = 0.f;
#pragma unroll
            for (int t = 0; t < 4; ++t) if (t < ntn) { const float dm = mt[t] - mean; q += m2[t] + 256.0f * dm * dm; }
            S[row] = (f32x2v){mean, 1.0f / sqrtf(q / (256.0f * (float)ntn) + eps)};
        }
        asm volatile("s_waitcnt lgkmcnt(0)" ::: "memory"); __builtin_amdgcn_s_barrier(); asm volatile("" ::: "memory");
        return bad;
    }
};
struct EpiLnRes {
    static constexpr bool PERM = false, AFTER_DRAIN = true;
    const float* base; float* out; int ldc; const float* bias; PanelStats st; unsigned poison;
    __device__ __forceinline__ void fused(f32x4 (&acc)[2][2][4][2], const Unit& u, int wr, int wc, int fr, int fq, PG8_LAS unsigned char* lds, int wid, int lane) const {
        typedef float f32x2v __attribute__((ext_vector_type(2)));
        const PG8_LAS f32x2v* S = (const PG8_LAS f32x2v*)(lds + 8192);
        const int col0 = u.pn * BM + wc * 32 + 4 * fq;
#pragma unroll
        for (int bj = 0; bj < 2; ++bj)
#pragma unroll
            for (int n = 0; n < 2; ++n) { const f32x4 bv = bias ? *(const f32x4*)(bias + col0 + bj * HALF + n * 16) : (f32x4){0.f, 0.f, 0.f, 0.f};
#pragma unroll
                for (int ai = 0; ai < 2; ++ai)
#pragma unroll
                    for (int m = 0; m < 4; ++m) acc[ai][bj][m][n] += bv; }
        f32x4 pre[4][2][2];
#pragma unroll
        for (int m = 0; m < 4; ++m) { const size_t off = (size_t)(u.pm * BM + wr * 64 + m * 16 + fr) * ldc + col0;
#pragma unroll
            for (int bj = 0; bj < 2; ++bj)
#pragma unroll
                for (int n = 0; n < 2; ++n) pre[m][bj][n] = *(const f32x4*)(base + off + bj * HALF + n * 16); }
        const bool bad = st.run(acc, u, wr, wc, fr, fq, lds, wid, lane) || poison != 0u;
        const float qnan = __builtin_nanf("");
#pragma unroll
        for (int ai = 0; ai < 2; ++ai)
#pragma unroll
            for (int m = 0; m < 4; ++m) { const int r = ai * HALF + wr * 64 + m * 16 + fr; const f32x2v sr = S[r]; const size_t off = (size_t)(u.pm * BM + r) * ldc + col0;
#pragma unroll
                for (int bj = 0; bj < 2; ++bj)
#pragma unroll
                    for (int n = 0; n < 2; ++n) { const f32x4 bs = ai == 0 ? pre[m][bj][n] : *(const f32x4*)(base + off + bj * HALF + n * 16); f32x4 o = bs + (acc[ai][bj][m][n] - sr.x) * sr.y;
                        if (bad) o = (f32x4){qnan, qnan, qnan, qnan}; *(f32x4*)(out + off + bj * HALF + n * 16) = o; }
                if (m & 1) asm volatile("" ::: "memory"); }
    }
};
struct EpiLnResLn {
    static constexpr bool PERM = false, AFTER_DRAIN = true;
    const float* base; float* out; bf16_t* xn; int ldc; const float* bias; PanelStats st1, st2; unsigned poison;
    __device__ __forceinline__ void fused(f32x4 (&acc)[2][2][4][2], const Unit& u, int wr, int wc, int fr, int fq, PG8_LAS unsigned char* lds, int wid, int lane) const {
        typedef float f32x2v __attribute__((ext_vector_type(2))); typedef unsigned u32x2v __attribute__((ext_vector_type(2)));
        const PG8_LAS f32x2v* S = (const PG8_LAS f32x2v*)(lds + 8192);
        const int col0 = u.pn * BM + wc * 32 + 4 * fq;
#pragma unroll
        for (int bj = 0; bj < 2; ++bj)
#pragma unroll
            for (int n = 0; n < 2; ++n) { const f32x4 bv = bias ? *(const f32x4*)(bias + col0 + bj * HALF + n * 16) : (f32x4){0.f, 0.f, 0.f, 0.f};
#pragma unroll
                for (int ai = 0; ai < 2; ++ai)
#pragma unroll
                    for (int m = 0; m < 4; ++m) acc[ai][bj][m][n] += bv; }
        bool bad = st1.run(acc, u, wr, wc, fr, fq, lds, wid, lane) || poison != 0u;
        const float qnan = __builtin_nanf("");
#pragma unroll
        for (int ai = 0; ai < 2; ++ai)
#pragma unroll
            for (int m = 0; m < 4; ++m) { const int r = ai * HALF + wr * 64 + m * 16 + fr; const f32x2v sr = S[r]; const size_t off = (size_t)(u.pm * BM + r) * ldc + col0;
#pragma unroll
                for (int bj = 0; bj < 2; ++bj)
#pragma unroll
                    for (int n = 0; n < 2; ++n) { const f32x4 bs = *(const f32x4*)(base + off + bj * HALF + n * 16); acc[ai][bj][m][n] = bs + (acc[ai][bj][m][n] - sr.x) * sr.y; }
                asm volatile("" : "+v"(acc[ai][0][m][0]), "+v"(acc[ai][0][m][1]), "+v"(acc[ai][1][m][0]), "+v"(acc[ai][1][m][1]));
                if (m & 1) asm volatile("" ::: "memory"); }
        const bool bad1 = bad;
        bad = st2.run(acc, u, wr, wc, fr, fq, lds, wid, lane) || bad;
#pragma unroll
        for (int ai = 0; ai < 2; ++ai)
#pragma unroll
            for (int m = 0; m < 4; ++m) { const int r = ai * HALF + wr * 64 + m * 16 + fr; const f32x2v sr = S[r]; const size_t off = (size_t)(u.pm * BM + r) * ldc + col0;
#pragma unroll
                for (int bj = 0; bj < 2; ++bj)
#pragma unroll
                    for (int n = 0; n < 2; ++n) { const f32x4 x1 = acc[ai][bj][m][n]; *(f32x4*)(out + off + bj * HALF + n * 16) = bad1 ? (f32x4){qnan, qnan, qnan, qnan} : x1;
                        const f32x4 o = (x1 - sr.x) * sr.y; u32x2v w; w.x = cvt_pk_bf16(o[0], o[1]); w.y = cvt_pk_bf16(o[2], o[3]);
                        if (bad) { w.x = 0x7fc07fc0u; w.y = 0x7fc07fc0u; } *(u32x2v*)(xn + off + bj * HALF + n * 16) = w; }
                asm volatile("" ::: "memory"); }
    }
};

template <class Epi, class Sched, bool ALIGN_EPI = false, bool SP2 = false>
__device__ __forceinline__ void gemm_phase(PG8_LAS unsigned char* lds, const Gemm g, const Sched& S, const Epi& E) {
    const int tid = threadIdx.x, wid = __builtin_amdgcn_readfirstlane(tid >> 6), lane = tid & 63, wr = wid >> 2, wc = wid & 3, fr = lane & 15, fq = lane >> 4;
    const int K = g.K, nt = K / BK;
    unsigned voffA[2], voffB[2];
#pragma unroll
    for (int i = 0; i < 2; ++i) { int R, C; stage_rc(tid * 16 + i * 8192, R, C); const int Rb = Epi::PERM ? ((R & ~31) + perm32(R & 31)) : R;
        voffA[i] = (unsigned)(R * K + C) * 2u; voffB[i] = (unsigned)(Rb * K + C) * 2u; }
    const size_t kstep = (size_t)(BK * 2);
    const size_t hstep = (size_t)HALF * K * 2;
    const size_t tstep = 2 * hstep;
    const unsigned ldsw = (unsigned)wid * 1024u;
    const int aoff = lds_byte(wr * 64 + fr, fq * 8), boff = lds_byte(wc * 32 + fr, fq * 8);
#define PG8_SA(b, h) (((b) * 2 + (h)) * HTB)
#define PG8_SB(b, h) ((4 + (b) * 2 + (h)) * HTB)
#define PG8_STAGE(bufoff, gbase, voff) do { _Pragma("unroll") for (int _i = 0; _i < 2; ++_i) \
        __builtin_amdgcn_global_load_lds((const unsigned*)((const char*)(gbase) + (voff)[_i]), (PG8_LAS unsigned*)(lds + (bufoff) + ldsw + _i * 8192), 16, 0, 0); } while (0)
#define PG8_LDA(dst, b, h) do { _Pragma("unroll") for (int m = 0; m < 4; ++m) _Pragma("unroll") for (int k = 0; k < 2; ++k) dst[m][k] = *(const PG8_LAS bf16x8*)(lds + PG8_SA(b, h) + aoff + m * 2048 + k * 1024); } while (0)
#define PG8_LDB(dst, b, h) do { _Pragma("unroll") for (int n = 0; n < 2; ++n) _Pragma("unroll") for (int k = 0; k < 2; ++k) dst[n][k] = *(const PG8_LAS bf16x8*)(lds + PG8_SB(b, h) + boff + n * 2048 + k * 1024); } while (0)
#define PG8_MMA(ai, bj, At, Bt) do { __builtin_amdgcn_s_setprio(1); _Pragma("unroll") for (int m = 0; m < 4; ++m) _Pragma("unroll") for (int n = 0; n < 2; ++n) _Pragma("unroll") for (int k = 0; k < 2; ++k) \
        acc[ai][bj][m][n] = __builtin_amdgcn_mfma_f32_16x16x32_bf16(Bt[n][k], At[m][k], acc[ai][bj][m][n], 0, 0, 0); __builtin_amdgcn_s_setprio(0); } while (0)
#define PG8_WAIT_V(n) asm volatile("s_waitcnt vmcnt(" #n ")" ::: "memory")
#define PG8_WAIT_L(n) asm volatile("s_waitcnt lgkmcnt(" #n ")" ::: "memory")
#define PG8_BAR __builtin_amdgcn_s_barrier()
#define PG8_SCHED __builtin_amdgcn_sched_barrier(0)
    Unit cur, nxt; int ui = 0;
    if (!S.next(0, cur)) return;
    f32x4 acc[2][2][4][2];
#pragma unroll
    for (int a = 0; a < 2; ++a)
#pragma unroll
        for (int b = 0; b < 2; ++b)
#pragma unroll
            for (int m = 0; m < 4; ++m)
#pragma unroll
                for (int n = 0; n < 2; ++n) acc[a][b][m][n] = (f32x4){0.f, 0.f, 0.f, 0.f};
    bf16x8 At[4][2], B0[2][2], B1[2][2];
    const char* cA = (const char*)g.A + (size_t)cur.pm * tstep; const char* cB = (const char*)g.Bt + (size_t)cur.pn * tstep;
    S.a_ready(cur);
    if constexpr (SP2) {
        PG8_STAGE(PG8_SB(0, 0), cB, voffB); PG8_STAGE(PG8_SB(0, 1), cB + hstep, voffB); PG8_STAGE(PG8_SA(0, 0), cA, voffA); PG8_STAGE(PG8_SA(0, 1), cA + hstep, voffA);
        if (wr == 1) PG8_BAR;
        PG8_WAIT_V(2); PG8_BAR;
        PG8_STAGE(PG8_SB(1, 0), cB + kstep, voffB); PG8_STAGE(PG8_SA(1, 0), cA + kstep, voffA); PG8_STAGE(PG8_SB(1, 1), cB + hstep + kstep, voffB);
        PG8_WAIT_V(6); PG8_BAR;
    } else {
        PG8_STAGE(PG8_SB(0, 0), cB, voffB); PG8_STAGE(PG8_SA(0, 0), cA, voffA); PG8_STAGE(PG8_SB(0, 1), cB + hstep, voffB); PG8_STAGE(PG8_SA(0, 1), cA + hstep, voffA);
        if (wr == 1) PG8_BAR;
        PG8_WAIT_V(4); PG8_BAR;
        PG8_STAGE(PG8_SB(1, 0), cB + kstep, voffB); PG8_STAGE(PG8_SA(1, 0), cA + kstep, voffA); PG8_STAGE(PG8_SB(1, 1), cB + hstep + kstep, voffB);
        PG8_WAIT_V(6); PG8_BAR;
    }
    for (;;) {
        const bool has_next = S.next(ui + 1, nxt);
        const char* nA = has_next ? (const char*)g.A + (size_t)nxt.pm * tstep : cA; const char* nB = has_next ? (const char*)g.Bt + (size_t)nxt.pn * tstep : cB;
        for (int t = 0; t < nt; t += 2) {
            const bool last = (t == nt - 2);
            const char* a1 = cA + (size_t)(t + 1) * kstep;
            const char* a2 = last ? nA : cA + (size_t)(t + 2) * kstep; const char* b2 = last ? nB : cB + (size_t)(t + 2) * kstep;
            const char* a3 = a2 + kstep; const char* b3 = b2 + kstep;
            if (last && has_next) S.a_ready(nxt);
            if constexpr (SP2) {
            PG8_LDB(B0, 0, 0); PG8_LDB(B1, 0, 1); PG8_SCHED; PG8_LDA(At, 0, 0); PG8_STAGE(PG8_SA(1, 1), a1 + hstep, voffA);
            PG8_WAIT_V(8); PG8_WAIT_L(0); PG8_BAR; PG8_MMA(0, 0, At, B0); PG8_MMA(0, 1, At, B1); PG8_BAR; PG8_SCHED;
            PG8_LDA(At, 0, 1); PG8_STAGE(PG8_SB(0, 0), b2, voffB); PG8_STAGE(PG8_SB(0, 1), b2 + hstep, voffB); PG8_STAGE(PG8_SA(0, 0), a2, voffA);
            PG8_WAIT_V(8); PG8_WAIT_L(0); PG8_BAR; PG8_MMA(1, 0, At, B0); PG8_MMA(1, 1, At, B1); PG8_BAR; PG8_SCHED;
            PG8_LDB(B0, 1, 0); PG8_LDB(B1, 1, 1); PG8_SCHED; PG8_LDA(At, 1, 0); PG8_STAGE(PG8_SA(0, 1), a2 + hstep, voffA);
            PG8_WAIT_V(8); PG8_WAIT_L(0); PG8_BAR; PG8_MMA(0, 0, At, B0); PG8_MMA(0, 1, At, B1); PG8_BAR; PG8_SCHED;
            PG8_LDA(At, 1, 1); PG8_STAGE(PG8_SB(1, 0), b3, voffB); PG8_STAGE(PG8_SB(1, 1), b3 + hstep, voffB); PG8_STAGE(PG8_SA(1, 0), a3, voffA);
            PG8_WAIT_V(8); PG8_WAIT_L(0); PG8_BAR; PG8_MMA(1, 0, At, B0); PG8_MMA(1, 1, At, B1); PG8_BAR; PG8_SCHED;
            } else {
            PG8_LDB(B0, 0, 0); PG8_SCHED; PG8_LDA(At, 0, 0); PG8_STAGE(PG8_SA(1, 1), a1 + hstep, voffA);
            PG8_WAIT_L(8); PG8_BAR; PG8_WAIT_L(0); PG8_MMA(0, 0, At, B0); PG8_BAR; PG8_SCHED;
            PG8_LDB(B1, 0, 1); PG8_STAGE(PG8_SB(0, 0), b2, voffB);
            PG8_BAR; PG8_WAIT_L(0); PG8_MMA(0, 1, At, B1); PG8_BAR;
            PG8_LDA(At, 0, 1); PG8_STAGE(PG8_SA(0, 0), a2, voffA);
            PG8_BAR; PG8_WAIT_L(0); PG8_MMA(1, 0, At, B0); PG8_BAR; PG8_SCHED;
            PG8_STAGE(PG8_SB(0, 1), b2 + hstep, voffB);
            PG8_WAIT_V(6); PG8_BAR; PG8_MMA(1, 1, At, B1); PG8_BAR;
            PG8_LDB(B0, 1, 0); PG8_SCHED; PG8_LDA(At, 1, 0); PG8_STAGE(PG8_SA(0, 1), a2 + hstep, voffA);
            PG8_WAIT_L(8); PG8_BAR; PG8_WAIT_L(0); PG8_MMA(0, 0, At, B0); PG8_BAR; PG8_SCHED;
            PG8_LDB(B1, 1, 1); PG8_STAGE(PG8_SB(1, 0), b3, voffB);
            PG8_BAR; PG8_WAIT_L(0); PG8_MMA(0, 1, At, B1); PG8_BAR;
            PG8_LDA(At, 1, 1); PG8_STAGE(PG8_SA(1, 0), a3, voffA);
            PG8_BAR; PG8_WAIT_L(0); PG8_MMA(1, 0, At, B0); PG8_BAR; PG8_SCHED;
            PG8_STAGE(PG8_SB(1, 1), b3 + hstep, voffB);
            PG8_WAIT_V(6); PG8_BAR; PG8_MMA(1, 1, At, B1); PG8_BAR;
            }
        }
        if constexpr (ALIGN_EPI) { if (wr == 0) PG8_BAR; }
        if constexpr (!Epi::AFTER_DRAIN) { E(acc, cur, wr, wc, fr, fq); S.done(cur); }
        if (!has_next) break;
#pragma unroll
        for (int a = 0; a < 2; ++a)
#pragma unroll
            for (int b = 0; b < 2; ++b)
#pragma unroll
                for (int m = 0; m < 4; ++m)
#pragma unroll
                    for (int n = 0; n < 2; ++n) acc[a][b][m][n] = (f32x4){0.f, 0.f, 0.f, 0.f};
        cur = nxt; cA = nA; cB = nB; ++ui;
        if constexpr (ALIGN_EPI) { if (wr == 1) PG8_BAR; }
    }
    PG8_WAIT_V(0);
    if constexpr (!ALIGN_EPI) { if (wr == 0) PG8_BAR; }
    PG8_BAR;
    if constexpr (Epi::AFTER_DRAIN) { E.fused(acc, cur, wr, wc, fr, fq, lds, wid, lane); S.done(cur); }
#undef PG8_SA
#undef PG8_SB
#undef PG8_STAGE
#undef PG8_LDA
#undef PG8_LDB
#undef PG8_MMA
#undef PG8_WAIT_V
#undef PG8_WAIT_L
#undef PG8_BAR
#undef PG8_SCHED
}
}
#define GAS __attribute__((address_space(1)))
#define LAS __attribute__((address_space(3)))
typedef unsigned short bf16;
typedef unsigned v4u __attribute__((ext_vector_type(4)));
typedef float f32x4 __attribute__((ext_vector_type(4)));
typedef short bf16x8 __attribute__((ext_vector_type(8)));
typedef GAS unsigned gu32;
typedef GAS unsigned long long gu64;
#define RLX_AGENT __ATOMIC_RELAXED, __HIP_MEMORY_SCOPE_AGENT
#define LDS_WAIT() asm volatile("s_waitcnt lgkmcnt(0)" ::: "memory")
#define VM_WAIT() asm volatile("s_waitcnt vmcnt(0)" ::: "memory")
__device__ __forceinline__ unsigned long long rt() { return __builtin_amdgcn_s_memrealtime(); }
__device__ __forceinline__ unsigned f2bf(float f) { unsigned u = __builtin_bit_cast(unsigned, f); return (u + 0x7fffu + ((u >> 16) & 1u)) >> 16; }
__device__ __forceinline__ unsigned pk2(float lo, float hi) { return f2bf(lo) | (f2bf(hi) << 16); }

#define XB_TMO      128
#define XB_XCNT(j)  (256  + 64 * (j))
#define XB_XSUB(j)  (1280 + 64 * (j))
#define XB_XGEN(j)  (2304 + 64 * (j))
#define XB_TOP      3328
#define XB_TOPGEN   3392
#define XCD_BAR_WORDS 3456
#define XB_SPIN_CAP (1u << 18)

__device__ __forceinline__ unsigned xb_ld(unsigned* p)              { return __hip_atomic_load(p, __ATOMIC_RELAXED, __HIP_MEMORY_SCOPE_AGENT); }
__device__ __forceinline__ unsigned xb_add(unsigned* p, unsigned v) { return __hip_atomic_fetch_add(p, v, __ATOMIC_RELAXED, __HIP_MEMORY_SCOPE_AGENT); }
__device__ __forceinline__ unsigned xb_xcc_id() { return (unsigned)__builtin_amdgcn_s_getreg((3 << 11) | 20) & 0xFu; }
#define XB_SPIN(cond, bar) do { unsigned _sp = 0; while (cond) { __builtin_amdgcn_s_sleep(1); \
    if ((++_sp & 255u) == 0u) { if (xb_ld(&(bar)[XB_TMO])) break; if (_sp > XB_SPIN_CAP) { atomicAdd(&(bar)[XB_TMO], 1u); break; } } } } while (0)

struct XcdBarrier {
    unsigned* bar; unsigned x;
    volatile LAS unsigned* st;
};

__device__ __forceinline__ XcdBarrier xcd_barrier_post(unsigned* bar, volatile LAS unsigned* st) {
    XcdBarrier b; b.bar = bar; b.x = xb_xcc_id(); b.st = st;
    if (threadIdx.x == 0) (void)xb_add(&bar[XB_XCNT(b.x)], 1u);
    return b;
}
__device__ __forceinline__ void xcd_barrier_complete(unsigned* bar, unsigned x, unsigned& nloc, unsigned& nx) {
    const unsigned G = gridDim.x * gridDim.y * gridDim.z;
    unsigned sum, cnt, mine, sp = 0u;
    for (;;) {
        sum = 0u; cnt = 0u; mine = 0u;
#pragma unroll
        for (unsigned j = 0; j < 16; ++j) { const unsigned c = xb_ld(&bar[XB_XCNT(j)]); sum += c; cnt += (c > 0u) ? 1u : 0u; mine = (j == x) ? c : mine; }
        if (sum == G) break;
        __builtin_amdgcn_s_sleep(1);
        if ((++sp & 255u) == 0u) { if (xb_ld(&bar[XB_TMO])) break; if (sp > XB_SPIN_CAP) { atomicAdd(&bar[XB_TMO], 1u); break; } }
    }
    nloc = mine > 0u ? mine : 1u; nx = cnt > 0u ? cnt : 1u;
}

__device__ __forceinline__ void xcd_barrier(const XcdBarrier& b) {
    asm volatile("s_waitcnt vmcnt(0)" ::: "memory");
    __syncthreads();
    if (threadIdx.x == 0) {
        unsigned* bar = b.bar;
        __builtin_amdgcn_s_waitcnt(0);
        unsigned nloc = b.st[0], nx = b.st[1];
        if (nloc == 0u) { xcd_barrier_complete(bar, b.x, nloc, nx); b.st[0] = nloc; b.st[1] = nx; }
        const unsigned old = xb_add(&bar[XB_XSUB(b.x)], 1u);
        const unsigned gen = old / nloc;
        if (old + 1u == (gen + 1u) * nloc) {
            __builtin_amdgcn_fence(__ATOMIC_RELEASE, "agent");
            asm volatile("s_waitcnt vmcnt(0)" ::: "memory");
            const unsigned og = xb_add(&bar[XB_TOP], 1u);
            const unsigned tg = og / nx;
            if (og + 1u == (tg + 1u) * nx) xb_add(&bar[XB_TOPGEN], 1u);
            else XB_SPIN(xb_ld(&bar[XB_TOPGEN]) == tg, bar);
            __builtin_amdgcn_fence(__ATOMIC_ACQUIRE, "agent");
            xb_add(&bar[XB_XGEN(b.x)], 1u);
            asm volatile("s_waitcnt vmcnt(0)" ::: "memory");
        } else {
            XB_SPIN(xb_ld(&bar[XB_XGEN(b.x)]) == gen, bar);
            __builtin_amdgcn_fence(__ATOMIC_ACQUIRE, "agent");
            asm volatile("s_waitcnt vmcnt(0)" ::: "memory");
        }
    }
    __syncthreads();
}

constexpr int NWAVES = 8;
constexpr int DM = 2048, NPROJ = 7168, SEQ = 2048, NBATCH = 4, MP = NBATCH * SEQ  , MS = 32, MTOK = MP + MS  , MPAD = 8448, MMEM = 1024;
constexpr int WA = 768, WM = 512, NMEM = 256, PASTW = 2048;
constexpr float QSCALE = 0.12751743082459868f;
constexpr float DN_ALPHA = 1.189207115002721f;
constexpr float LN_EPS = 1e-5f, RMS_EPS = 1e-6f;
constexpr size_t OUT_Y = 0, OUT_YS = 16777216, OUT_KP = 16842752, OUT_VP = 23134208, OUT_SP = 29425664, OUT_MKP = 29818880, OUT_MVP = 30343168,
                 OUT_KS = 30867456, OUT_VS = 30892032, OUT_SS = 30916608, OUT_TOTAL = 34062336;
constexpr size_t MiB = 1u << 20;
constexpr size_t WS_CTL = 0, CTL_ZERO_BYTES = 1 * MiB;
constexpr size_t WS_LB = 1 * MiB;
constexpr size_t WS_COS = 2 * MiB, WS_SIN = 3 * MiB;
constexpr size_t WS_XB = 4 * MiB;
constexpr size_t WS_WT = 42 * MiB;
constexpr size_t WS_WOUTT = 74 * MiB;
constexpr size_t WS_QA = 82 * MiB, WS_KA = 95 * MiB, WS_VA = 108 * MiB, WS_GA = 121 * MiB;
constexpr size_t WS_QB = 134 * MiB, WS_KB = 147 * MiB, WS_VB = 160 * MiB, WS_GB = 173 * MiB;
constexpr size_t WS_LF = 186 * MiB;
constexpr size_t WS_QM = 211 * MiB, WS_GM = 220 * MiB;
constexpr size_t WS_MK = 229 * MiB, WS_MV = 230 * MiB;
constexpr size_t WS_Z = 231 * MiB;
constexpr size_t WS_OP = 264 * MiB;
constexpr size_t WS_LSE = 300 * MiB;
constexpr size_t WS_U = 301 * MiB, WS_SPV = 325 * MiB;
constexpr size_t WS_DC = 349 * MiB;
constexpr size_t WS_RS = 350 * MiB;
constexpr size_t WS_SAMP = 351 * MiB;
constexpr size_t WS_HO = 353 * MiB;
constexpr size_t WS_END = 384 * MiB;
constexpr int CW_BAR = 4096;
constexpr int RING_OFF = 0, RING_BYTES = 131072;
constexpr int LDSCTL_OFF = RING_BYTES, MISC_OFF = LDSCTL_OFF + 320;
constexpr int LDS_BYTES = 147456;

struct Args { const float* in[15]; float* out; unsigned char* ws; };

__device__ __forceinline__ float bf2f(unsigned h) { return __uint_as_float(h << 16); }
__device__ __forceinline__ float bflo(unsigned w) { return __uint_as_float(w << 16); }
__device__ __forceinline__ float bfhi(unsigned w) { return __uint_as_float(w & 0xffff0000u); }
__device__ __forceinline__ float wave_sum(float v) {
#pragma unroll
    for (int o = 1; o < 64; o <<= 1) v += __shfl_xor(v, o);
    return v;
}
__device__ __forceinline__ float sigmoidf_(float x) { return __builtin_amdgcn_rcpf(1.0f + __builtin_amdgcn_exp2f(-1.4426950408889634f * x)); }
__device__ __forceinline__ float siluf_(float x) { return x * sigmoidf_(x); }

namespace pg8 {
__host__ __device__ __forceinline__ int rowmap_win(int n) { if (n < 1536) { const int d = n & 127; return (n & ~127) + 8 * ((d & 63) >> 2) + 4 * (d >> 6) + (d & 3); } return n; }

struct EpiProj {
    static constexpr bool PERM = true, AFTER_DRAIN = false;
    unsigned char* ws; float* out;
    __device__ __forceinline__ void operator()(const f32x4 (&acc)[2][2][4][2], const Unit& u, int wr, int wc, int fr, int fq) const {
        const int pn = u.pn, pm = u.pm;
        int seg, colt;
        if (pn < 24) { seg = pn / 3; colt = (pn % 3) * 256; } else if (pn < 28) { seg = 8 + ((pn - 24) >> 1); colt = ((pn - 24) & 1) * 256; } else { seg = 10 + ((pn - 28) >> 1); colt = ((pn - 28) & 1) * 256; }
        const float* cosT = (const float*)(ws + WS_COS); const float* sinT = (const float*)(ws + WS_SIN); const float* LB = (const float*)(ws + WS_LB);
#pragma unroll
        for (int ai = 0; ai < 2; ++ai)
#pragma unroll
            for (int m = 0; m < 4; ++m) {
                const int row = pm * BM + ai * HALF + wr * 64 + m * 16 + fr;
#pragma unroll
                for (int bj = 0; bj < 2; ++bj) {
                    const int c0 = colt + bj * HALF + wc * 32 + 8 * fq;
                    f32x4 v0 = acc[ai][bj][m][0], v1 = acc[ai][bj][m][1];
                    if (seg >= 10) {
                        const int mr = row - MPAD;
                        float* o = out + (seg == 10 ? OUT_MKP : OUT_MVP) + (size_t)mr * WM + c0;
                        *(f32x4*)o = v0; *(f32x4*)(o + 4) = v1;
                        bf16_t* b = (bf16_t*)(ws + (seg == 10 ? WS_MK : WS_MV)) + (size_t)mr * WM + c0;
                        u32x4 w; w.x = cvt_pk_bf16(v0[0], v0[1]); w.y = cvt_pk_bf16(v0[2], v0[3]); w.z = cvt_pk_bf16(v1[0], v1[1]); w.w = cvt_pk_bf16(v1[2], v1[3]);
                        *(u32x4*)b = w;
                        continue;
                    }
                    if (seg <= 1) {
                        const int i0 = 4 * ((c0 & 127) >> 3);
                        const int pr = row < MP ? (row & (SEQ - 1)) : SEQ;
                        const f32x4 cs = *(const f32x4*)(cosT + pr * 64 + i0), sn = *(const f32x4*)(sinT + pr * 64 + i0);
                        const f32x4 o1 = v0 * cs - v1 * sn, o2 = v1 * cs + v0 * sn;
                        if (seg == 1) {
                            if (row < MTOK) {
                                float* o = (row < MP ? out + OUT_KP + (size_t)row * WA : out + OUT_KS + (size_t)(row - MP) * WA) + (c0 & ~127) + i0;
                                *(f32x4*)o = o1; *(f32x4*)(o + 64) = o2;
                            }
                            v0 = o1; v1 = o2;
                        } else { v0 = o1 * QSCALE; v1 = o2 * QSCALE; }
                    } else if (seg == 2) {
                        if (row < MTOK) {
                            float* o = (row < MP ? out + OUT_VP + (size_t)row * WA : out + OUT_VS + (size_t)(row - MP) * WA) + c0;
                            *(f32x4*)o = v0; *(f32x4*)(o + 4) = v1;
                        }
                    } else if (seg == 3 || seg == 7 || seg == 9) {
#pragma unroll
                        for (int e = 0; e < 4; ++e) { v0[e] = siluf_(v0[e]); v1[e] = siluf_(v1[e]); }
                    } else if (seg == 5) {
                        const f32x4 la = *(const f32x4*)(LB + c0), lb = *(const f32x4*)(LB + c0 + 4);
                        f32x4 l0, l1;
#pragma unroll
                        for (int e = 0; e < 4; ++e) {
                            const float sa = sigmoidf_(v0[e]), sb = sigmoidf_(v1[e]);
                            const float fa = la[e] + (1.0f - la[e]) * sa, fb = lb[e] + (1.0f - lb[e]) * sb;
                            l0[e] = __logf(fa); l1[e] = __logf(fb);
                            v0[e] = (1.0f - la[e]) * (1.0f - sa); v1[e] = (1.0f - lb[e]) * (1.0f - sb);
                        }
                        float* lf = (float*)(ws + WS_LF) + (size_t)row * WA + c0;
                        *(f32x4*)lf = l0; *(f32x4*)(lf + 4) = l1;
                    } else if (seg == 8) { v0 = v0 * QSCALE; v1 = v1 * QSCALE; }
                    size_t boff; int ld;
                    if (seg < 8) { boff = WS_QA + (size_t)seg * 13 * MiB; ld = WA; } else { boff = (seg == 8 ? WS_QM : WS_GM); ld = WM; }
                    bf16_t* b = (bf16_t*)(ws + boff) + (size_t)row * ld + c0;
                    u32x4 w; w.x = cvt_pk_bf16(v0[0], v0[1]); w.y = cvt_pk_bf16(v0[2], v0[3]); w.z = cvt_pk_bf16(v1[0], v1[1]); w.w = cvt_pk_bf16(v1[2], v1[3]);
                    *(u32x4*)b = w;
                }
            }
    }
};
static_assert(WS_KA == WS_QA + 13 * MiB && WS_VA == WS_QA + 26 * MiB && WS_GA == WS_QA + 39 * MiB && WS_QB == WS_QA + 52 * MiB && WS_KB == WS_QA + 65 * MiB && WS_VB == WS_QA + 78 * MiB && WS_GB == WS_QA + 91 * MiB, "segment buffers 13 MiB apart");

struct SchedProj {
    int G, c;
    __device__ __forceinline__ bool next(int i, Unit& u) const {
        const int L = i * G + c; constexpr int nM = 33, nN = 28, nwg = nM * nN;
        if (L >= nwg + 16) return false;
        if (L >= nwg) { const int j = L - nwg; u.pm = nM + (j >> 2); u.pn = nN + (j & 3); return true; }
        int wgid = L; { const int q = nwg / NXCD, r = nwg % NXCD, xcd = wgid % NXCD, off = wgid / NXCD; wgid = (xcd < r ? xcd * (q + 1) : r * (q + 1) + (xcd - r) * q) + off; }
        const int nig = WGM * nN, gid = wgid / nig, fm = gid * WGM, gsz = (nM - fm) < WGM ? (nM - fm) : WGM;
        u.pm = fm + ((wgid % nig) % gsz); u.pn = (wgid % nig) / gsz; return true;
    }
    __device__ __forceinline__ void a_ready(const Unit&) const {}
    __device__ __forceinline__ void done(const Unit&) const {}
};

struct EpiRes {
    static constexpr bool PERM = false, AFTER_DRAIN = false;
    const float* x; float* out;
    __device__ __forceinline__ void operator()(const f32x4 (&acc)[2][2][4][2], const Unit& u, int wr, int wc, int fr, int fq) const {
#pragma unroll
        for (int ai = 0; ai < 2; ++ai)
#pragma unroll
            for (int m = 0; m < 4; ++m) {
                const size_t ro = (size_t)(u.pm * BM + ai * HALF + wr * 64 + m * 16 + fr) * DM;
#pragma unroll
                for (int bj = 0; bj < 2; ++bj)
#pragma unroll
                    for (int n = 0; n < 2; ++n) {
                        const int col = u.pn * BM + bj * HALF + wc * 32 + n * 16 + 4 * fq;
                        const f32x4 xv = *(const f32x4*)(x + ro + col);
                        *(f32x4*)(out + ro + col) = acc[ai][bj][m][n] + xv * DN_ALPHA;
                    }
            }
    }
};
}

struct Frame {
    LAS unsigned char* lds;
    int tid, lane, wave, vcu, G, gw, NGW;
    unsigned char* ws; float* out;
    const float* in[15];
};

template <bool PERMROWS>
__device__ __forceinline__ void p0_transpose_item(const float* W, int K, int N, bf16* WT, int row_off, LAS float* scr, int item, int lane) {
    const int nblk = N / 32, kb = item / nblk, nb = item % nblk, k0 = 64 * kb, n0 = 32 * nb;
#pragma unroll 8
    for (int i = 0; i < 32; ++i) { const int kk = 2 * i + (lane >> 5); scr[kk * 33 + (lane & 31)] = W[(size_t)(k0 + kk) * N + n0 + (lane & 31)]; }
    LDS_WAIT(); asm volatile("" ::: "memory");
    const int c = lane & 7;
#pragma unroll
    for (int j = 0; j < 4; ++j) { const int n = (lane >> 3) + 8 * j; const LAS float* s = scr + (8 * c) * 33 + n;
        v4u o; o.x = pk2(s[0 * 33], s[1 * 33]); o.y = pk2(s[2 * 33], s[3 * 33]); o.z = pk2(s[4 * 33], s[5 * 33]); o.w = pk2(s[6 * 33], s[7 * 33]);
        const int drow = row_off + (PERMROWS ? pg8::rowmap_win(n0 + n) : n0 + n);
        *(GAS v4u*)(WT + (size_t)drow * K + k0 + 8 * c) = o; }
    LDS_WAIT(); asm volatile("" ::: "memory");
}
__device__ __forceinline__ void p0_prologue(Frame& F) {
    LAS float* scr = (LAS float*)(F.lds + RING_OFF + F.wave * 16384);
    const float* w_in = F.in[8]; const float* w_mem = F.in[9]; const float* w_out = F.in[12];
    bf16* WT = (bf16*)(F.ws + WS_WT); bf16* WOT = (bf16*)(F.ws + WS_WOUTT); bf16* XB = (bf16*)(F.ws + WS_XB);
    constexpr int I_IN = (DM / 64) * (NPROJ / 32), I_MEM = (DM / 64) * (1024 / 32), I_OUT = (DM / 64) * (DM / 32);
    for (int it = F.gw; it < I_IN + I_MEM + I_OUT; it += F.NGW) {
        int r = it;
        if (r < I_IN) { p0_transpose_item<true>(w_in, DM, NPROJ, WT, 0, scr, r, F.lane); continue; } r -= I_IN;
        if (r < I_MEM) { p0_transpose_item<false>(w_mem, DM, 1024, WT, NPROJ, scr, r, F.lane); continue; } r -= I_MEM;
        p0_transpose_item<false>(w_out, DM, DM, WOT, 0, scr, r, F.lane);
    }
    for (int m = F.gw; m < MPAD + MMEM; m += F.NGW) {
        GAS unsigned long long* o8 = (GAS unsigned long long*)(XB + (size_t)m * DM) + F.lane;
        if (m >= MTOK && m < MPAD) {
#pragma unroll
            for (int j = 0; j < 8; ++j) o8[64 * j] = 0ull;
            continue;
        }
        const float* src = m < MP ? F.in[0] + (size_t)m * DM : (m < MTOK ? F.in[1] + (size_t)(m - MP) * DM : F.in[7] + (size_t)(m - MPAD) * DM);
        const GAS f32x4* xr = (const GAS f32x4*)src + F.lane;
        f32x4 v[8];
#pragma unroll
        for (int j = 0; j < 8; ++j) v[j] = xr[64 * j];
#pragma unroll
        for (int j = 0; j < 8; ++j) o8[64 * j] = (unsigned long long)pk2(v[j].x, v[j].y) | ((unsigned long long)pk2(v[j].z, v[j].w) << 32);
    }
    {
        float* cosT = (float*)(F.ws + WS_COS); float* sinT = (float*)(F.ws + WS_SIN);
        const int gt = F.gw * 64 + F.lane, NT = F.NGW * 64;
        for (int e = gt; e < (SEQ + 1) * 64; e += NT) {
            const int pr = e >> 6, i = e & 63; const double pos = pr < SEQ ? (double)pr : 8192.0;
            double inv = 1.0; for (int k = 0; k < i; ++k) inv *= 0.8659643233600653;
            const double ang = pos * inv; const double kq = __builtin_floor(ang * 0.15915494309189535); const float red = (float)(ang - kq * 6.283185307179586);
            cosT[e] = cosf(red); sinT[e] = sinf(red);
        }
        float* LB = (float*)(F.ws + WS_LB); const float* raw = F.in[10];
        for (int e = gt; e < WA; e += NT) LB[e] = 1.0f / (1.0f + expf(raw[WA + e] - raw[e]));
    }
}

struct SM { float m, l, a0, a1; };
__device__ __forceinline__ void sm_step(SM& s, float sc, float v0, float v1) {
    const float mn = fmaxf(s.m, sc), f = __builtin_amdgcn_exp2f(s.m - mn), p = __builtin_amdgcn_exp2f(sc - mn);
    s.l = s.l * f + p; s.a0 = s.a0 * f + p * v0; s.a1 = s.a1 * f + p * v1; s.m = mn;
}
__device__ __forceinline__ void naive_attn_task(Frame& F, int task) {
    const int lane = F.lane; const bf16* QA = (const bf16*)(F.ws + WS_QA); const bf16* KA = (const bf16*)(F.ws + WS_KA); const bf16* VA = (const bf16*)(F.ws + WS_VA); const bf16* GA = (const bf16*)(F.ws + WS_GA);
    bf16* Z = (bf16*)(F.ws + WS_Z);
    const int r = task / 6, h = task % 6;
    SM s{-1e30f, 0.f, 0.f, 0.f};
    if (r < MP) {
        const int t = r & (SEQ - 1);
        const unsigned qq = *(const unsigned*)(QA + (size_t)r * WA + h * 128 + 2 * lane); const float q0 = bflo(qq), q1 = bfhi(qq);
        for (int br = 0; br < 3; ++br) {
            const int dil = br == 0 ? 1 : (br == 1 ? 4 : 16); int cnt = t / dil; cnt = (cnt < 128 ? cnt : 128) + 1;
            for (int j = 0; j < cnt; ++j) {
                const size_t ko = (size_t)(r - j * dil) * WA + h * 128 + 2 * lane;
                const unsigned kk = *(const unsigned*)(KA + ko), vv = *(const unsigned*)(VA + ko);
                const float sc = wave_sum(q0 * bflo(kk) + q1 * bfhi(kk));
                sm_step(s, sc, bflo(vv), bfhi(vv));
            }
        }
    } else {
        const int bs = r - MP; const int p = 8 * (((2 * lane) & 63) >> 2) + 4 * (lane >> 5) + ((2 * lane) & 3);
        const unsigned qq = *(const unsigned*)(QA + (size_t)r * WA + h * 128 + p); const float q0 = bflo(qq), q1 = bfhi(qq);
        const float* ck = F.in[2]; const float* cv = F.in[3];
        const float2 kn = *(const float2*)(F.out + OUT_KS + (size_t)bs * WA + h * 128 + 2 * lane), vn = *(const float2*)(F.out + OUT_VS + (size_t)bs * WA + h * 128 + 2 * lane);
        const float scn = wave_sum(q0 * kn.x + q1 * kn.y);
        for (int br = 0; br < 3; ++br) {
            const int dil = br == 0 ? 1 : (br == 1 ? 4 : 16);
            sm_step(s, scn, vn.x, vn.y);
            for (int j = 1; j <= 128; ++j) {
                const size_t ko = ((size_t)(bs * PASTW + PASTW - j * dil) * 6 + h) * 128 + 2 * lane;
                const float2 k2 = *(const float2*)(ck + ko), v2 = *(const float2*)(cv + ko);
                const float sc = wave_sum(q0 * k2.x + q1 * k2.y);
                sm_step(s, sc, v2.x, v2.y);
            }
        }
    }
    const float il = 1.0f / s.l; const unsigned gg = *(const unsigned*)(GA + (size_t)r * WA + h * 128 + 2 * lane);
    *(unsigned*)(Z + (size_t)r * DM + h * 128 + 2 * lane) = pk2(s.a0 * il * bflo(gg), s.a1 * il * bfhi(gg));
}
__device__ __forceinline__ void naive_mem_task(Frame& F, int task) {
    const int lane = F.lane; const bf16* QM = (const bf16*)(F.ws + WS_QM); const bf16* GM = (const bf16*)(F.ws + WS_GM); const bf16* MK = (const bf16*)(F.ws + WS_MK); const bf16* MV = (const bf16*)(F.ws + WS_MV);
    bf16* Z = (bf16*)(F.ws + WS_Z);
    const int r = task >> 2, h = task & 3;
    const unsigned qq = *(const unsigned*)(QM + (size_t)r * WM + h * 128 + 2 * lane); const float q0 = bflo(qq), q1 = bfhi(qq);
    SM s{-1e30f, 0.f, 0.f, 0.f};
    if (r < MP) {
        const int b = r >> 11;
        for (int m = 0; m < NMEM; ++m) {
            const size_t ko = (size_t)(b * NMEM + m) * WM + h * 128 + 2 * lane;
            const unsigned kk = *(const unsigned*)(MK + ko), vv = *(const unsigned*)(MV + ko);
            const float sc = wave_sum(q0 * bflo(kk) + q1 * bfhi(kk));
            sm_step(s, sc, bflo(vv), bfhi(vv));
        }
    } else {
        const int bs = r - MP; const float* ck = F.in[5]; const float* cv = F.in[6];
        for (int m = 0; m < NMEM; ++m) {
            const size_t ko = ((size_t)(bs * NMEM + m) * 4 + h) * 128 + 2 * lane;
            const float2 k2 = *(const float2*)(ck + ko), v2 = *(const float2*)(cv + ko);
            const float sc = wave_sum(q0 * k2.x + q1 * k2.y);
            sm_step(s, sc, v2.x, v2.y);
        }
    }
    const float il = 1.0f / s.l; const unsigned gg = *(const unsigned*)(GM + (size_t)r * WM + h * 128 + 2 * lane);
    *(unsigned*)(Z + (size_t)r * DM + 1536 + h * 128 + 2 * lane) = pk2(s.a0 * il * bflo(gg), s.a1 * il * bfhi(gg));
}
__device__ __forceinline__ void naive_hgrn_prompt_item(Frame& F, int item) {
    const int lane = F.lane; const int vb = item & 15, bh = item >> 4, h = bh % 6, b = bh / 6;
    const bf16* QB = (const bf16*)(F.ws + WS_QB); const bf16* KB = (const bf16*)(F.ws + WS_KB); const bf16* VB = (const bf16*)(F.ws + WS_VB); const float* LF = (const float*)(F.ws + WS_LF);
    float* HO = (float*)(F.ws + WS_HO);
    float S0[8], S1[8];
#pragma unroll
    for (int j = 0; j < 8; ++j) { S0[j] = 0.f; S1[j] = 0.f; }
    for (int t = 0; t < SEQ; ++t) {
        const size_t ro = (size_t)(b * SEQ + t) * WA + h * 128;
        const float qa = bf2f(QB[ro + lane]), qb = bf2f(QB[ro + lane + 64]), ka = bf2f(KB[ro + lane]), kb = bf2f(KB[ro + lane + 64]);
        const float fa = __expf(LF[ro + lane]), fb = __expf(LF[ro + lane + 64]);
        const v4u vv = *(const v4u*)(VB + ro + vb * 8);
        float v[8] = {bflo(vv.x), bfhi(vv.x), bflo(vv.y), bfhi(vv.y), bflo(vv.z), bfhi(vv.z), bflo(vv.w), bfhi(vv.w)};
        float o[8];
#pragma unroll
        for (int j = 0; j < 8; ++j) { S0[j] = fa * S0[j] + ka * v[j]; S1[j] = fb * S1[j] + kb * v[j]; o[j] = wave_sum(qa * S0[j] + qb * S1[j]); }
        if (lane == 0) { *(f32x4*)(HO + ro + vb * 8) = (f32x4){o[0], o[1], o[2], o[3]}; *(f32x4*)(HO + ro + vb * 8 + 4) = (f32x4){o[4], o[5], o[6], o[7]}; }
    }
    float* so = F.out + OUT_SP + ((size_t)bh * 128) * 128 + vb * 8;
    *(f32x4*)(so + (size_t)lane * 128) = (f32x4){S0[0], S0[1], S0[2], S0[3]}; *(f32x4*)(so + (size_t)lane * 128 + 4) = (f32x4){S0[4], S0[5], S0[6], S0[7]};
    *(f32x4*)(so + (size_t)(lane + 64) * 128) = (f32x4){S1[0], S1[1], S1[2], S1[3]}; *(f32x4*)(so + (size_t)(lane + 64) * 128 + 4) = (f32x4){S1[4], S1[5], S1[6], S1[7]};
}
__device__ __forceinline__ void hgrn_sample_item(Frame& F, int item) {
    const int lane = F.lane; const int kb = item & 7, bh = item >> 3, h = bh % 6, bs = bh / 6; const int r = MP + bs;
    const bf16* QB = (const bf16*)(F.ws + WS_QB); const bf16* KB = (const bf16*)(F.ws + WS_KB); const bf16* VB = (const bf16*)(F.ws + WS_VB); const float* LF = (const float*)(F.ws + WS_LF);
    const size_t ro = (size_t)r * WA + h * 128;
    const unsigned vv = *(const unsigned*)(VB + ro + 2 * lane); const float v0 = bflo(vv), v1 = bfhi(vv);
    const float* sp = F.in[4] + ((size_t)bh * 128 + kb * 16) * 128 + 2 * lane; float* sn = F.out + OUT_SS + ((size_t)bh * 128 + kb * 16) * 128 + 2 * lane;
    float o0 = 0.f, o1 = 0.f;
#pragma unroll 4
    for (int k = 0; k < 16; ++k) {
        const int kk = kb * 16 + k;
        const float q = bf2f(QB[ro + kk]), kf = bf2f(KB[ro + kk]), f = __expf(LF[ro + kk]);
        const float2 s = *(const float2*)(sp + (size_t)k * 128);
        const float n0 = f * s.x + kf * v0, n1 = f * s.y + kf * v1;
        *(float2*)(sn + (size_t)k * 128) = make_float2(n0, n1);
        o0 += q * n0; o1 += q * n1;
    }
    float* po = (float*)(F.ws + WS_SAMP) + ((size_t)bh * 8 + kb) * 128 + 2 * lane;
    *(float2*)po = make_float2(o0, o1);
}
__device__ __forceinline__ void hgrn_norm_task(Frame& F, int task) {
    const int lane = F.lane; const int r = task / 6, h = task % 6;
    const bf16* GB = (const bf16*)(F.ws + WS_GB); bf16* Z = (bf16*)(F.ws + WS_Z); const float* ng = F.in[11];
    float o0, o1;
    if (r < MP) { const float2 o = *(const float2*)((const float*)(F.ws + WS_HO) + (size_t)r * WA + h * 128 + 2 * lane); o0 = o.x; o1 = o.y; }
    else { const int bh = (r - MP) * 6 + h; o0 = 0.f; o1 = 0.f;
#pragma unroll
        for (int kb = 0; kb < 8; ++kb) { const float2 o = *(const float2*)((const float*)(F.ws + WS_SAMP) + ((size_t)bh * 8 + kb) * 128 + 2 * lane); o0 += o.x; o1 += o.y; } }
    const float ss = wave_sum(o0 * o0 + o1 * o1); const float rs = 1.0f / sqrtf(ss * (1.0f / 128.0f) + RMS_EPS);
    const unsigned gg = *(const unsigned*)(GB + (size_t)r * WA + h * 128 + 2 * lane); const float2 g2 = *(const float2*)(ng + h * 128 + 2 * lane);
    *(unsigned*)(Z + (size_t)r * DM + WA + h * 128 + 2 * lane) = pk2(o0 * rs * g2.x * bflo(gg), o1 * rs * g2.y * bfhi(gg));
}

__device__ __forceinline__ void sample_outproj(Frame& F) {
    const bf16* Z = (const bf16*)(F.ws + WS_Z); const bf16* WOT = (const bf16*)(F.ws + WS_WOUTT); float* RS = (float*)(F.ws + WS_RS);
    LAS float* red = (LAS float*)(F.lds + RING_OFF);
    for (int cb = F.vcu; cb < DM / 8; cb += F.G) {
        const int idx = F.tid & 255, half = F.tid >> 8, row = idx >> 3, col = cb * 8 + (idx & 7);
        const v4u* zp = (const v4u*)(Z + (size_t)(MP + row) * DM + half * 1024); const v4u* wp = (const v4u*)(WOT + (size_t)col * DM + half * 1024);
        float acc = 0.f;
        for (int k = 0; k < 128; ++k) { const v4u a = zp[k], b = wp[k];
            acc += bflo(a.x) * bflo(b.x) + bfhi(a.x) * bfhi(b.x) + bflo(a.y) * bflo(b.y) + bfhi(a.y) * bfhi(b.y) + bflo(a.z) * bflo(b.z) + bfhi(a.z) * bfhi(b.z) + bflo(a.w) * bflo(b.w) + bfhi(a.w) * bfhi(b.w); }
        __syncthreads();
        if (half == 1) red[idx] = acc;
        __syncthreads();
        if (half == 0) RS[(size_t)row * DM + col] = acc + red[idx] + DN_ALPHA * F.in[1][(size_t)row * DM + col];
    }
    __syncthreads();
}
__device__ __forceinline__ void ln_row(Frame& F, const float* rrow, float* orow) {
    const GAS f32x4* xr = (const GAS f32x4*)rrow + F.lane; const GAS f32x4* gp = (const GAS f32x4*)F.in[13] + F.lane; const GAS f32x4* bp = (const GAS f32x4*)F.in[14] + F.lane;
    f32x4 v[8]; float s = 0.f;
#pragma unroll
    for (int j = 0; j < 8; ++j) { v[j] = xr[64 * j]; s += (v[j].x + v[j].y) + (v[j].z + v[j].w); }
    const float mean = wave_sum(s) * (1.f / DM); float s2 = 0.f;
#pragma unroll
    for (int j = 0; j < 8; ++j) { v[j] = v[j] - mean; s2 += (v[j].x * v[j].x + v[j].y * v[j].y) + (v[j].z * v[j].z + v[j].w * v[j].w); }
    const float rstd = 1.f / sqrtf(wave_sum(s2) * (1.f / DM) + LN_EPS);
    GAS f32x4* op = (GAS f32x4*)orow + F.lane;
#pragma unroll
    for (int j = 0; j < 8; ++j) op[64 * j] = v[j] * rstd * gp[64 * j] + bp[64 * j];
}

__global__ void __launch_bounds__(NWAVES * 64, 2) fwd_kernel(Args args) {
    extern __shared__ __attribute__((aligned(16))) unsigned char lds[];
    Frame F;
    F.lds = (LAS unsigned char*)lds;
    F.tid = threadIdx.x; F.lane = F.tid & 63; F.wave = __builtin_amdgcn_readfirstlane(F.tid >> 6);
    F.G = gridDim.x; { const int bx = blockIdx.x; F.vcu = (F.G % 8 == 0) ? (bx % 8) * (F.G / 8) + bx / 8 : bx; }
    F.gw = F.vcu * NWAVES + F.wave; F.NGW = F.G * NWAVES;
    F.ws = args.ws; F.out = args.out;
#pragma unroll
    for (int i = 0; i < 15; ++i) F.in[i] = args.in[i];
    gu32* ctl = (gu32*)(F.ws + WS_CTL);
    volatile LAS unsigned* MISC = (volatile LAS unsigned*)(F.lds + MISC_OFF);
    for (int u = F.tid; u < (LDS_BYTES - LDSCTL_OFF) / 4; u += NWAVES * 64) ((LAS unsigned*)(F.lds + LDSCTL_OFF))[u] = 0u;
    __syncthreads();
    XcdBarrier bar = xcd_barrier_post((unsigned*)(ctl + CW_BAR), MISC + 8);

    p0_prologue(F);
    xcd_barrier(bar);
    {
        pg8::Gemm g{(const pg8::bf16_t*)(F.ws + WS_XB), (const pg8::bf16_t*)(F.ws + WS_WT), MPAD + MMEM, NPROJ + 1024, DM};
        pg8::SchedProj S{F.G, (int)blockIdx.x};
        pg8::EpiProj E{F.ws, F.out};
        pg8::gemm_phase<pg8::EpiProj, pg8::SchedProj, true, true>(F.lds + RING_OFF, g, S, E);
    }
    xcd_barrier(bar);
    {
        constexpr int N_HP = NBATCH * 6 * 16, N_HS = MS * 6 * 8, N_AT = MTOK * 6, N_ME = MTOK * 4;
        for (int it = F.gw; it < N_HP + N_HS + N_AT + N_ME; it += F.NGW) {
            int r = it;
            if (r < N_HP) { naive_hgrn_prompt_item(F, r); continue; } r -= N_HP;
            if (r < N_HS) { hgrn_sample_item(F, r); continue; } r -= N_HS;
            if (r < N_AT) { naive_attn_task(F, r); continue; } r -= N_AT;
            naive_mem_task(F, r);
        }
    }
    xcd_barrier(bar);
    for (int it = F.gw; it < MTOK * 6; it += F.NGW) hgrn_norm_task(F, it);
    xcd_barrier(bar);
    {
        sample_outproj(F);
        pg8::Gemm g{(const pg8::bf16_t*)(F.ws + WS_Z), (const pg8::bf16_t*)(F.ws + WS_WOUTT), MP, DM, DM};
        pg8::StaticOrder S; S.init(MP, DM, F.G, (int)blockIdx.x);
        pg8::EpiRes E{F.in[0], F.out + OUT_Y};
        pg8::gemm_phase<pg8::EpiRes, pg8::StaticOrder, true, true>(F.lds + RING_OFF, g, S, E);
    }
    xcd_barrier(bar);
    for (int m = F.gw; m < MTOK; m += F.NGW) {
        if (m < MP) ln_row(F, F.out + OUT_Y + (size_t)m * DM, F.out + OUT_Y + (size_t)m * DM);
        else ln_row(F, (const float*)(F.ws + WS_RS) + (size_t)(m - MP) * DM, F.out + OUT_YS + (size_t)(m - MP) * DM);
    }
}

extern "C" void kernel_launch(void* const* d_in, const int* in_sizes, int n_in, void* d_out, int out_size, void* d_ws, size_t ws_size, hipStream_t stream) {
    static int grid = 0;
    if (grid == 0) {
        if (n_in != 15 || out_size != (int)OUT_TOTAL || ws_size < WS_END) { fprintf(stderr, "kernel_launch: unexpected shapes (n_in %d out %d ws %zu)\n", n_in, out_size, ws_size); grid = -1; return; }
        int dev = 0, cus = 0, per_cu = 0;
        if (hipGetDevice(&dev) != hipSuccess || hipDeviceGetAttribute(&cus, hipDeviceAttributeMultiprocessorCount, dev) != hipSuccess) { grid = -1; return; }
        if (hipFuncSetAttribute((const void*)fwd_kernel, hipFuncAttributeMaxDynamicSharedMemorySize, LDS_BYTES) != hipSuccess) { fprintf(stderr, "kernel_launch: hipFuncSetAttribute failed\n"); grid = -1; return; }
        if (hipOccupancyMaxActiveBlocksPerMultiprocessor(&per_cu, (const void*)fwd_kernel, NWAVES * 64, LDS_BYTES) != hipSuccess || per_cu < 1) { fprintf(stderr, "kernel_launch: occupancy query says %d blocks per CU\n", per_cu); per_cu = 1; }
        (void)hipGetLastError();
        grid = cus;
    }
    if (grid < 0) return;
    if (hipMemsetAsync((char*)d_ws + WS_CTL, 0, CTL_ZERO_BYTES, stream) != hipSuccess) { fprintf(stderr, "kernel_launch: memset failed\n"); return; }
    Args a{};
    for (int i = 0; i < 15; ++i) a.in[i] = (const float*)d_in[i];
    a.out = (float*)d_out; a.ws = (unsigned char*)d_ws;
    hipLaunchKernelGGL(fwd_kernel, dim3(grid), dim3(NWAVES * 64), LDS_BYTES, stream, a);
}
```

```cpp
#include <hip/hip_runtime.h>
#include <cstdio>
#include <cstdint>
#include <hip/hip_runtime.h>
#include <cstdio>
#include <cstdint>
namespace pg8 {
#define PG8_LAS __attribute__((address_space(3)))
typedef unsigned short bf16_t;
typedef short bf16x8 __attribute__((ext_vector_type(8)));
typedef float f32x4 __attribute__((ext_vector_type(4)));
typedef unsigned u32x4 __attribute__((ext_vector_type(4)));
constexpr int BM = 256, BK = 64, HALF = 128, HTB = HALF * BK * 2  , STAGE_BYTES = 8 * HTB, NXCD = 8, WGM = 8;

__host__ __device__ __forceinline__ int lds_byte(int r, int c) { const int st = (r >> 4) * 2 + (c >> 5), rr = r & 15, cc = c & 31, ob = rr * 64 + cc * 2; return st * 1024 + (ob ^ (((ob >> 9) & 1) << 5)); }
__host__ __device__ __forceinline__ void stage_rc(int b, int& R, int& C) { const int st = b / 1024, sb = b % 1024, swz = sb ^ (((sb >> 9) & 1) << 5); R = (st >> 1) * 16 + swz / 64; C = (st & 1) * 32 + (swz % 64) / 2; }
__host__ __device__ __forceinline__ int perm32(int rho) { const int n = rho >> 4, i = rho & 15; return 8 * (i >> 2) + 4 * n + (i & 3); }

struct Unit { int pm, pn; };
struct Gemm { const bf16_t* A; const bf16_t* Bt; int M, N, K; };

struct StaticOrder {
    int nM, nN, nwg, G, c;
    __host__ __device__ void init(int M, int N, int G_, int c_) { nM = M / BM; nN = N / BM; nwg = nM * nN; G = G_; c = c_; }
    __host__ __device__ bool next(int i, Unit& u) const {
        const long L = (long)i * G + c; if (L >= nwg) return false;
        int wgid = (int)L; { const int q = nwg / NXCD, r = nwg % NXCD, xcd = wgid % NXCD, off = wgid / NXCD; wgid = (xcd < r ? xcd * (q + 1) : r * (q + 1) + (xcd - r) * q) + off; }
        const int nig = WGM * nN, gid = wgid / nig, fm = gid * WGM, gsz = (nM - fm) < WGM ? (nM - fm) : WGM;
        u.pm = fm + ((wgid % nig) % gsz); u.pn = (wgid % nig) / gsz; return true;
    }
    __device__ __forceinline__ void a_ready(const Unit&) const {}
    __device__ __forceinline__ void done(const Unit&) const {}
};

__device__ __forceinline__ unsigned cvt_pk_bf16(float lo, float hi) { unsigned r; asm volatile("v_cvt_pk_bf16_f32 %0, %1, %2" : "=v"(r) : "v"(lo), "v"(hi)); return r; }
typedef float f32x2 __attribute__((ext_vector_type(2)));
__device__ __forceinline__ f32x2 gelu_pk(f32x2 v) {
    const f32x2 av = __builtin_elementwise_abs(v), d = av * 0.2316418882f + 1.0f;
    f32x2 t; t.x = __builtin_amdgcn_rcpf(d.x); t.y = __builtin_amdgcn_rcpf(d.y);
    f32x2 q = t * 0.5307027145f + (-0.7265760135f); q = q * t + 0.7107068705f; q = q * t + (-0.142248368f); q = q * t + 0.127414796f; q = q * t;
    const f32x2 s = (v * v) * (-0.72134752044f);
    f32x2 e; e.x = __builtin_amdgcn_exp2f(s.x); e.y = __builtin_amdgcn_exp2f(s.y);
    const f32x2 m = v * (q * e), r = v - m;
    f32x2 o; o.x = v.x < 0.f ? m.x : r.x; o.y = v.y < 0.f ? m.y : r.y; return o;
}

template <int ACT  > struct EpiBf16 {
    static constexpr bool PERM = true, AFTER_DRAIN = false; static_assert(ACT == 0 || ACT == 1, "EpiBf16: ACT is 0 (none) or 1 (gelu_pk)");
    bf16_t* O; int ldc; const float* bias; int split_cols; size_t split_stride; float scale0;
    __device__ __forceinline__ void operator()(const f32x4 (&acc)[2][2][4][2], const Unit& u, int wr, int wc, int fr, int fq) const {
        const int row0 = u.pm * BM + wr * 64 + fr; int colt = u.pn * BM; bf16_t* base = O;
        float sc = 1.f; if (split_cols) { const int t = colt / split_cols; base += (size_t)t * split_stride; colt -= t * split_cols; if (t == 0) sc = scale0; }
        const int col0 = colt + wc * 32 + 8 * fq, bcol0 = u.pn * BM + wc * 32 + 8 * fq;
        f32x4 bv[2][2];
#pragma unroll
        for (int bj = 0; bj < 2; ++bj)
#pragma unroll
            for (int n = 0; n < 2; ++n) bv[bj][n] = bias ? *(const f32x4*)(bias + bcol0 + bj * HALF + 4 * n) : (f32x4){0.f, 0.f, 0.f, 0.f};
#pragma unroll
        for (int ai = 0; ai < 2; ++ai)
#pragma unroll
            for (int m = 0; m < 4; ++m) { bf16_t* rowp = base + (size_t)(row0 + ai * HALF + m * 16) * ldc + col0;
#pragma unroll
                for (int bj = 0; bj < 2; ++bj) { f32x4 v0 = acc[ai][bj][m][0] + bv[bj][0], v1 = acc[ai][bj][m][1] + bv[bj][1];
                    if (ACT == 1) { f32x2 a = gelu_pk((f32x2){v0[0], v0[1]}), b = gelu_pk((f32x2){v0[2], v0[3]}), c = gelu_pk((f32x2){v1[0], v1[1]}), d = gelu_pk((f32x2){v1[2], v1[3]});
                        v0 = (f32x4){a.x, a.y, b.x, b.y}; v1 = (f32x4){c.x, c.y, d.x, d.y}; }
                    v0 = v0 * sc; v1 = v1 * sc; u32x4 w; w.x = cvt_pk_bf16(v0[0], v0[1]); w.y = cvt_pk_bf16(v0[2], v0[3]); w.z = cvt_pk_bf16(v1[0], v1[1]); w.w = cvt_pk_bf16(v1[2], v1[3]);
                    *(u32x4*)(rowp + bj * HALF) = w; } }
    }
};

struct PanelStats {
    unsigned* xbuf;
    unsigned* cnt;
    unsigned* tmo;
    int ntn; float eps;
    unsigned code;
    __device__ __forceinline__ bool run(const f32x4 (&v)[2][2][4][2], const Unit& u, int wr, int wc, int fr, int fq, PG8_LAS unsigned char* lds, int wid, int lane) const {
        typedef float f32x2v __attribute__((ext_vector_type(2)));
        PG8_LAS f32x2v* P = (PG8_LAS f32x2v*)lds;
        PG8_LAS f32x2v* S = (PG8_LAS f32x2v*)(lds + 8192);
        PG8_LAS unsigned* flag = (PG8_LAS unsigned*)(lds + 8192 + 2048);
#pragma unroll
        for (int ai = 0; ai < 2; ++ai)
#pragma unroll
            for (int m = 0; m < 4; ++m) {
                float s = 0.f;
#pragma unroll
                for (int bj = 0; bj < 2; ++bj)
#pragma unroll
                    for (int n = 0; n < 2; ++n) { const f32x4 x = v[ai][bj][m][n]; s += (x[0] + x[1]) + (x[2] + x[3]); }
                s += __shfl_xor(s, 16); s += __shfl_xor(s, 32);
                const float mw = s * (1.0f / 64.0f); float q = 0.f;
#pragma unroll
                for (int bj = 0; bj < 2; ++bj)
#pragma unroll
                    for (int n = 0; n < 2; ++n) { const f32x4 d = v[ai][bj][m][n] - mw; q += (d[0] * d[0] + d[1] * d[1]) + (d[2] * d[2] + d[3] * d[3]); }
                q += __shfl_xor(q, 16); q += __shfl_xor(q, 32);
                if (fq == 0) P[(ai * HALF + wr * 64 + m * 16 + fr) * 4 + wc] = (f32x2v){mw, q};
            }
        asm volatile("s_waitcnt lgkmcnt(0)" ::: "memory"); __builtin_amdgcn_s_barrier(); asm volatile("" ::: "memory");
#if defined(BROKEN_EXCHANGE_NO_WAIT)
#warning BROKEN CONTROL BUILD: the row-statistics exchange does not wait; results are wrong by design
        if (blockIdx.x >= 64) { const long long t0_ = clock64(); while (clock64() - t0_ < 60000) __builtin_amdgcn_s_sleep(8); }
#endif
        const int row = wid * 32 + (lane & 31);
        if (lane < 32) {
            const f32x2v a = P[row * 4 + 0], b = P[row * 4 + 1], c = P[row * 4 + 2], d = P[row * 4 + 3];
            const float mt = (a.x + b.x + c.x + d.x) * 0.25f;
            const float da = a.x - mt, db = b.x - mt, dc = c.x - mt, dd = d.x - mt;
            const float m2 = (a.y + b.y) + (c.y + d.y) + 64.0f * ((da * da + db * db) + (dc * dc + dd * dd));
            unsigned long long* slot = (unsigned long long*)xbuf + ((size_t)(u.pm * BM + row) * 4 + u.pn);
            __hip_atomic_store(slot, ((unsigned long long)__float_as_uint(m2) << 32) | __float_as_uint(mt), __ATOMIC_RELAXED, __HIP_MEMORY_SCOPE_AGENT);
        }
        asm volatile("s_waitcnt vmcnt(0)" ::: "memory");
        if (lane == 0) __hip_atomic_fetch_add(cnt + 64 * u.pm, 1u, __ATOMIC_RELAXED, __HIP_MEMORY_SCOPE_AGENT);
        if (wid == 0) {
            bool dead = false; const unsigned long long t0 = __builtin_amdgcn_s_memrealtime(); const unsigned want = 8u * (unsigned)ntn;
            for (;;) {
#if defined(BROKEN_EXCHANGE_NO_WAIT)
                break;
#endif
                if ((unsigned)__builtin_amdgcn_readfirstlane(__hip_atomic_load(cnt + 64 * u.pm, __ATOMIC_RELAXED, __HIP_MEMORY_SCOPE_AGENT)) >= want) break;
                if (__builtin_amdgcn_s_memrealtime() - t0 > 2000000ull) {
                    if (lane == 0) { unsigned expect = 0u; __hip_atomic_compare_exchange_strong(tmo + 1, &expect, code | (unsigned)(u.pm & 0xff), __ATOMIC_RELAXED, __ATOMIC_RELAXED, __HIP_MEMORY_SCOPE_AGENT);
                                     __hip_atomic_store(tmo, 1u, __ATOMIC_RELAXED, __HIP_MEMORY_SCOPE_AGENT); }
                    dead = true; break; }
                __builtin_amdgcn_s_sleep(2);
            }
            __builtin_amdgcn_fence(__ATOMIC_ACQUIRE, "agent");
            if (lane == 0) flag[0] = dead ? 1u : 0u;
        }
        asm volatile("s_waitcnt vmcnt(0) lgkmcnt(0)" ::: "memory"); __builtin_amdgcn_s_barrier(); asm volatile("" ::: "memory");
        const bool bad = flag[0] != 0u;
        if (lane < 32) {
            const unsigned long long* slot = (const unsigned long long*)xbuf + (size_t)(u.pm * BM + row) * 4; float mt[4], m2[4]; float ms = 0.f;
#pragma unroll
            for (int t = 0; t < 4; ++t) { if (t < ntn) { const unsigned long long w = __hip_atomic_load(slot + t, __ATOMIC_RELAXED, __HIP_MEMORY_SCOPE_AGENT); mt[t] = __uint_as_float((unsigned)w); m2[t] = __uint_as_float((unsigned)(w >> 32)); } else { mt[t] = 0.f; m2[t] = 0.f; } ms += mt[t]; }
            const float mean = ms / (float)ntn; float q = 0.f;
#pragma unroll
            for (int t = 0; t < 4; ++t) if (t < ntn) { const float dm = mt[t] - mean; q += m2[t] + 256.0f * dm * dm; }
            S[row] = (f32x2v){mean, 1.0f / sqrtf(q / (256.0f * (float)ntn) + eps)};
        }
        asm volatile("s_waitcnt lgkmcnt(0)" ::: "memory"); __builtin_amdgcn_s_barrier(); asm volatile("" ::: "memory");
        return bad;
    }
};
struct EpiLnRes {
    static constexpr bool PERM = false, AFTER_DRAIN = true;
    const float* base; float* out; int ldc; const float* bias; PanelStats st; unsigned poison;
    __device__ __forceinline__ void fused(f32x4 (&acc)[2][2][4][2], const Unit& u, int wr, int wc, int fr, int fq, PG8_LAS unsigned char* lds, int wid, int lane) const {
        typedef float f32x2v __attribute__((ext_vector_type(2)));
        const PG8_LAS f32x2v* S = (const PG8_LAS f32x2v*)(lds + 8192);
        const int col0 = u.pn * BM + wc * 32 + 4 * fq;
#pragma unroll
        for (int bj = 0; bj < 2; ++bj)
#pragma unroll
            for (int n = 0; n < 2; ++n) { const f32x4 bv = bias ? *(const f32x4*)(bias + col0 + bj * HALF + n * 16) : (f32x4){0.f, 0.f, 0.f, 0.f};
#pragma unroll
                for (int ai = 0; ai < 2; ++ai)
#pragma unroll
                    for (int m = 0; m < 4; ++m) acc[ai][bj][m][n] += bv; }
        f32x4 pre[4][2][2];
#pragma unroll
        for (int m = 0; m < 4; ++m) { const size_t off = (size_t)(u.pm * BM + wr * 64 + m * 16 + fr) * ldc + col0;
#pragma unroll
            for (int bj = 0; bj < 2; ++bj)
#pragma unroll
                for (int n = 0; n < 2; ++n) pre[m][bj][n] = *(const f32x4*)(base + off + bj * HALF + n * 16); }
        const bool bad = st.run(acc, u, wr, wc, fr, fq, lds, wid, lane) || poison != 0u;
        const float qnan = __builtin_nanf("");
#pragma unroll
        for (int ai = 0; ai < 2; ++ai)
#pragma unroll
            for (int m = 0; m < 4; ++m) { const int r = ai * HALF + wr * 64 + m * 16 + fr; const f32x2v sr = S[r]; const size_t off = (size_t)(u.pm * BM + r) * ldc + col0;
#pragma unroll
                for (int bj = 0; bj < 2; ++bj)
#pragma unroll
                    for (int n = 0; n < 2; ++n) { const f32x4 bs = ai == 0 ? pre[m][bj][n] : *(const f32x4*)(base + off + bj * HALF + n * 16); f32x4 o = bs + (acc[ai][bj][m][n] - sr.x) * sr.y;
                        if (bad) o = (f32x4){qnan, qnan, qnan, qnan}; *(f32x4*)(out + off + bj * HALF + n * 16) = o; }
                if (m & 1) asm volatile("" ::: "memory"); }
    }
};
struct EpiLnResLn {
    static constexpr bool PERM = false, AFTER_DRAIN = true;
    const float* base; float* out; bf16_t* xn; int ldc; const float* bias; PanelStats st1, st2; unsigned poison;
    __device__ __forceinline__ void fused(f32x4 (&acc)[2][2][4][2], const Unit& u, int wr, int wc, int fr, int fq, PG8_LAS unsigned char* lds, int wid, int lane) const {
        typedef float f32x2v __attribute__((ext_vector_type(2))); typedef unsigned u32x2v __attribute__((ext_vector_type(2)));
        const PG8_LAS f32x2v* S = (const PG8_LAS f32x2v*)(lds + 8192);
        const int col0 = u.pn * BM + wc * 32 + 4 * fq;
#pragma unroll
        for (int bj = 0; bj < 2; ++bj)
#pragma unroll
            for (int n = 0; n < 2; ++n) { const f32x4 bv = bias ? *(const f32x4*)(bias + col0 + bj * HALF + n * 16) : (f32x4){0.f, 0.f, 0.f, 0.f};
#pragma unroll
                for (int ai = 0; ai < 2; ++ai)
#pragma unroll
                    for (int m = 0; m < 4; ++m) acc[ai][bj][m][n] += bv; }
        bool bad = st1.run(acc, u, wr, wc, fr, fq, lds, wid, lane) || poison != 0u;
        const float qnan = __builtin_nanf("");
#pragma unroll
        for (int ai = 0; ai < 2; ++ai)
#pragma unroll
            for (int m = 0; m < 4; ++m) { const int r = ai * HALF + wr * 64 + m * 16 + fr; const f32x2v sr = S[r]; const size_t off = (size_t)(u.pm * BM + r) * ldc + col0;
#pragma unroll
                for (int bj = 0; bj < 2; ++bj)
#pragma unroll
                    for (int n = 0; n < 2; ++n) { const f32x4 bs = *(const f32x4*)(base + off + bj * HALF + n * 16); acc[ai][bj][m][n] = bs + (acc[ai][bj][m][n] - sr.x) * sr.y; }
                asm volatile("" : "+v"(acc[ai][0][m][0]), "+v"(acc[ai][0][m][1]), "+v"(acc[ai][1][m][0]), "+v"(acc[ai][1][m][1]));
                if (m & 1) asm volatile("" ::: "memory"); }
        const bool bad1 = bad;
        bad = st2.run(acc, u, wr, wc, fr, fq, lds, wid, lane) || bad;
#pragma unroll
        for (int ai = 0; ai < 2; ++ai)
#pragma unroll
            for (int m = 0; m < 4; ++m) { const int r = ai * HALF + wr * 64 + m * 16 + fr; const f32x2v sr = S[r]; const size_t off = (size_t)(u.pm * BM + r) * ldc + col0;
#pragma unroll
                for (int bj = 0; bj < 2; ++bj)
#pragma unroll
                    for (int n = 0; n < 2; ++n) { const f32x4 x1 = acc[ai][bj][m][n]; *(f32x4*)(out + off + bj * HALF + n * 16) = bad1 ? (f32x4){qnan, qnan, qnan, qnan} : x1;
                        const f32x4 o = (x1 - sr.x) * sr.y; u32x2v w; w.x = cvt_pk_bf16(o[0], o[1]); w.y = cvt_pk_bf16(o[2], o[3]);
                        if (bad) { w.x = 0x7fc07fc0u; w.y = 0x7fc07fc0u; } *(u32x2v*)(xn + off + bj * HALF + n * 16) = w; }
                asm volatile("" ::: "memory"); }
    }
};

template <class Epi, class Sched, bool ALIGN_EPI = false, bool SP2 = false>
__device__ __forceinline__ void gemm_phase(PG8_LAS unsigned char* lds, const Gemm g, const Sched& S, const Epi& E) {
    const int tid = threadIdx.x, wid = __builtin_amdgcn_readfirstlane(tid >> 6), lane = tid & 63, wr = wid >> 2, wc = wid & 3, fr = lane & 15, fq = lane >> 4;
    const int K = g.K, nt = K / BK;
    unsigned voffA[2], voffB[2];
#pragma unroll
    for (int i = 0; i < 2; ++i) { int R, C; stage_rc(tid * 16 + i * 8192, R, C); const int Rb = Epi::PERM ? ((R & ~31) + perm32(R & 31)) : R;
        voffA[i] = (unsigned)(R * K + C) * 2u; voffB[i] = (unsigned)(Rb * K + C) * 2u; }
    const size_t kstep = (size_t)(BK * 2);
    const size_t hstep = (size_t)HALF * K * 2;
    const size_t tstep = 2 * hstep;
    const unsigned ldsw = (unsigned)wid * 1024u;
    const int aoff = lds_byte(wr * 64 + fr, fq * 8), boff = lds_byte(wc * 32 + fr, fq * 8);
#define PG8_SA(b, h) (((b) * 2 + (h)) * HTB)
#define PG8_SB(b, h) ((4 + (b) * 2 + (h)) * HTB)
#define PG8_STAGE(bufoff, gbase, voff) do { _Pragma("unroll") for (int _i = 0; _i < 2; ++_i) \
        __builtin_amdgcn_global_load_lds((const unsigned*)((const char*)(gbase) + (voff)[_i]), (PG8_LAS unsigned*)(lds + (bufoff) + ldsw + _i * 8192), 16, 0, 0); } while (0)
#define PG8_LDA(dst, b, h) do { _Pragma("unroll") for (int m = 0; m < 4; ++m) _Pragma("unroll") for (int k = 0; k < 2; ++k) dst[m][k] = *(const PG8_LAS bf16x8*)(lds + PG8_SA(b, h) + aoff + m * 2048 + k * 1024); } while (0)
#define PG8_LDB(dst, b, h) do { _Pragma("unroll") for (int n = 0; n < 2; ++n) _Pragma("unroll") for (int k = 0; k < 2; ++k) dst[n][k] = *(const PG8_LAS bf16x8*)(lds + PG8_SB(b, h) + boff + n * 2048 + k * 1024); } while (0)
#define PG8_MMA(ai, bj, At, Bt) do { __builtin_amdgcn_s_setprio(1); _Pragma("unroll") for (int m = 0; m < 4; ++m) _Pragma("unroll") for (int n = 0; n < 2; ++n) _Pragma("unroll") for (int k = 0; k < 2; ++k) \
        acc[ai][bj][m][n] = __builtin_amdgcn_mfma_f32_16x16x32_bf16(Bt[n][k], At[m][k], acc[ai][bj][m][n], 0, 0, 0); __builtin_amdgcn_s_setprio(0); } while (0)
#define PG8_WAIT_V(n) asm volatile("s_waitcnt vmcnt(" #n ")" ::: "memory")
#define PG8_WAIT_L(n) asm volatile("s_waitcnt lgkmcnt(" #n ")" ::: "memory")
#define PG8_BAR __builtin_amdgcn_s_barrier()
#define PG8_SCHED __builtin_amdgcn_sched_barrier(0)
    Unit cur, nxt; int ui = 0;
    if (!S.next(0, cur)) return;
    f32x4 acc[2][2][4][2];
#pragma unroll
    for (int a = 0; a < 2; ++a)
#pragma unroll
        for (int b = 0; b < 2; ++b)
#pragma unroll
            for (int m = 0; m < 4; ++m)
#pragma unroll
                for (int n = 0; n < 2; ++n) acc[a][b][m][n] = (f32x4){0.f, 0.f, 0.f, 0.f};
    bf16x8 At[4][2], B0[2][2], B1[2][2];
    const char* cA = (const char*)g.A + (size_t)cur.pm * tstep; const char* cB = (const char*)g.Bt + (size_t)cur.pn * tstep;
    S.a_ready(cur);
    if constexpr (SP2) {
        PG8_STAGE(PG8_SB(0, 0), cB, voffB); PG8_STAGE(PG8_SB(0, 1), cB + hstep, voffB); PG8_STAGE(PG8_SA(0, 0), cA, voffA); PG8_STAGE(PG8_SA(0, 1), cA + hstep, voffA);
        if (wr == 1) PG8_BAR;
        PG8_WAIT_V(2); PG8_BAR;
        PG8_STAGE(PG8_SB(1, 0), cB + kstep, voffB); PG8_STAGE(PG8_SA(1, 0), cA + kstep, voffA); PG8_STAGE(PG8_SB(1, 1), cB + hstep + kstep, voffB);
        PG8_WAIT_V(6); PG8_BAR;
    } else {
        PG8_STAGE(PG8_SB(0, 0), cB, voffB); PG8_STAGE(PG8_SA(0, 0), cA, voffA); PG8_STAGE(PG8_SB(0, 1), cB + hstep, voffB); PG8_STAGE(PG8_SA(0, 1), cA + hstep, voffA);
        if (wr == 1) PG8_BAR;
        PG8_WAIT_V(4); PG8_BAR;
        PG8_STAGE(PG8_SB(1, 0), cB + kstep, voffB); PG8_STAGE(PG8_SA(1, 0), cA + kstep, voffA); PG8_STAGE(PG8_SB(1, 1), cB + hstep + kstep, voffB);
        PG8_WAIT_V(6); PG8_BAR;
    }
    for (;;) {
        const bool has_next = S.next(ui + 1, nxt);
        const char* nA = has_next ? (const char*)g.A + (size_t)nxt.pm * tstep : cA; const char* nB = has_next ? (const char*)g.Bt + (size_t)nxt.pn * tstep : cB;
        for (int t = 0; t < nt; t += 2) {
            const bool last = (t == nt - 2);
            const char* a1 = cA + (size_t)(t + 1) * kstep;
            const char* a2 = last ? nA : cA + (size_t)(t + 2) * kstep; const char* b2 = last ? nB : cB + (size_t)(t + 2) * kstep;
            const char* a3 = a2 + kstep; const char* b3 = b2 + kstep;
            if (last && has_next) S.a_ready(nxt);
            if constexpr (SP2) {
            PG8_LDB(B0, 0, 0); PG8_LDB(B1, 0, 1); PG8_SCHED; PG8_LDA(At, 0, 0); PG8_STAGE(PG8_SA(1, 1), a1 + hstep, voffA);
            PG8_WAIT_V(8); PG8_WAIT_L(0); PG8_BAR; PG8_MMA(0, 0, At, B0); PG8_MMA(0, 1, At, B1); PG8_BAR; PG8_SCHED;
            PG8_LDA(At, 0, 1); PG8_STAGE(PG8_SB(0, 0), b2, voffB); PG8_STAGE(PG8_SB(0, 1), b2 + hstep, voffB); PG8_STAGE(PG8_SA(0, 0), a2, voffA);
            PG8_WAIT_V(8); PG8_WAIT_L(0); PG8_BAR; PG8_MMA(1, 0, At, B0); PG8_MMA(1, 1, At, B1); PG8_BAR; PG8_SCHED;
            PG8_LDB(B0, 1, 0); PG8_LDB(B1, 1, 1); PG8_SCHED; PG8_LDA(At, 1, 0); PG8_STAGE(PG8_SA(0, 1), a2 + hstep, voffA);
            PG8_WAIT_V(8); PG8_WAIT_L(0); PG8_BAR; PG8_MMA(0, 0, At, B0); PG8_MMA(0, 1, At, B1); PG8_BAR; PG8_SCHED;
            PG8_LDA(At, 1, 1); PG8_STAGE(PG8_SB(1, 0), b3, voffB); PG8_STAGE(PG8_SB(1, 1), b3 + hstep, voffB); PG8_STAGE(PG8_SA(1, 0), a3, voffA);
            PG8_WAIT_V(8); PG8_WAIT_L(0); PG8_BAR; PG8_MMA(1, 0, At, B0); PG8_MMA(1, 1, At, B1); PG8_BAR; PG8_SCHED;
            } else {
            PG8_LDB(B0, 0, 0); PG8_SCHED; PG8_LDA(At, 0, 0); PG8_STAGE(PG8_SA(1, 1), a1 + hstep, voffA);
            PG8_WAIT_L(8); PG8_BAR; PG8_WAIT_L(0); PG8_MMA(0, 0, At, B0); PG8_BAR; PG8_SCHED;
            PG8_LDB(B1, 0, 1); PG8_STAGE(PG8_SB(0, 0), b2, voffB);
            PG8_BAR; PG8_WAIT_L(0); PG8_MMA(0, 1, At, B1); PG8_BAR;
            PG8_LDA(At, 0, 1); PG8_STAGE(PG8_SA(0, 0), a2, voffA);
            PG8_BAR; PG8_WAIT_L(0); PG8_MMA(1, 0, At, B0); PG8_BAR; PG8_SCHED;
            PG8_STAGE(PG8_SB(0, 1), b2 + hstep, voffB);
            PG8_WAIT_V(6); PG8_BAR; PG8_MMA(1, 1, At, B1); PG8_BAR;
            PG8_LDB(B0, 1, 0); PG8_SCHED; PG8_LDA(At, 1, 0); PG8_STAGE(PG8_SA(0, 1), a2 + hstep, voffA);
            PG8_WAIT_L(8); PG8_BAR; PG8_WAIT_L(0); PG8_MMA(0, 0, At, B0); PG8_BAR; PG8_SCHED;
            PG8_LDB(B1, 1, 1); PG8_STAGE(PG8_SB(1, 0), b3, voffB);
            PG8_BAR; PG8_WAIT_L(0); PG8_MMA(0, 1, At, B1); PG8_BAR;
            PG8_LDA(At, 1, 1); PG8_STAGE(PG8_SA(1, 0), a3, voffA);
            PG8_BAR; PG8_WAIT_L(0); PG8_MMA(1, 0, At, B0); PG8_BAR; PG8_SCHED;
            PG8_STAGE(PG8_SB(1, 1), b3 + hstep, voffB);
            PG8_WAIT_V(6); PG8_BAR; PG8_MMA(1, 1, At, B1); PG8_BAR;
            }
        }
        if constexpr (ALIGN_EPI) { if (wr == 0) PG8_BAR; }
        if constexpr (!Epi::AFTER_DRAIN) { E(acc, cur, wr, wc, fr, fq); S.done(cur); }
        if (!has_next) break;
#pragma unroll
        for (int a = 0; a < 2; ++a)
#pragma unroll
            for (int b = 0; b < 2; ++b)
#pragma unroll
                for (int m = 0; m < 4; ++m)
#pragma unroll
                    for (int n = 0; n < 2; ++n) acc[a][b][m][n] = (f32x4){0.f, 0.f, 0.f, 0.f};
        cur = nxt; cA = nA; cB = nB; ++ui;
        if constexpr (ALIGN_EPI) { if (wr == 1) PG8_BAR; }
    }
    PG8_WAIT_V(0);
    if constexpr (!ALIGN_EPI) { if (wr == 0) PG8_BAR; }
    PG8_BAR;
    if constexpr (Epi::AFTER_DRAIN) { E.fused(acc, cur, wr, wc, fr, fq, lds, wid, lane); S.done(cur); }
#undef PG8_SA
#undef PG8_SB
#undef PG8_STAGE
#undef PG8_LDA
#undef PG8_LDB
#undef PG8_MMA
#undef PG8_WAIT_V
#undef PG8_WAIT_L
#undef PG8_BAR
#undef PG8_SCHED
}
}
#define GAS __attribute__((address_space(1)))
#define LAS __attribute__((address_space(3)))
typedef unsigned short bf16;
typedef unsigned v4u __attribute__((ext_vector_type(4)));
typedef float f32x4 __attribute__((ext_vector_type(4)));
typedef short bf16x8 __attribute__((ext_vector_type(8)));
typedef GAS unsigned gu32;
typedef GAS unsigned long long gu64;
#define RLX_AGENT __ATOMIC_RELAXED, __HIP_MEMORY_SCOPE_AGENT
#define LDS_WAIT() asm volatile("s_waitcnt lgkmcnt(0)" ::: "memory")
#define VM_WAIT() asm volatile("s_waitcnt vmcnt(0)" ::: "memory")
__device__ __forceinline__ unsigned long long rt() { return __builtin_amdgcn_s_memrealtime(); }
__device__ __forceinline__ unsigned f2bf(float f) { unsigned u = __builtin_bit_cast(unsigned, f); return (u + 0x7fffu + ((u >> 16) & 1u)) >> 16; }
__device__ __forceinline__ unsigned pk2(float lo, float hi) { return f2bf(lo) | (f2bf(hi) << 16); }

#define XB_TMO      128
#define XB_XCNT(j)  (256  + 64 * (j))
#define XB_XSUB(j)  (1280 + 64 * (j))
#define XB_XGEN(j)  (2304 + 64 * (j))
#define XB_TOP      3328
#define XB_TOPGEN   3392
#define XCD_BAR_WORDS 3456
#define XB_SPIN_CAP (1u << 18)

__device__ __forceinline__ unsigned xb_ld(unsigned* p)              { return __hip_atomic_load(p, __ATOMIC_RELAXED, __HIP_MEMORY_SCOPE_AGENT); }
__device__ __forceinline__ unsigned xb_add(unsigned* p, unsigned v) { return __hip_atomic_fetch_add(p, v, __ATOMIC_RELAXED, __HIP_MEMORY_SCOPE_AGENT); }
__device__ __forceinline__ unsigned xb_xcc_id() { return (unsigned)__builtin_amdgcn_s_getreg((3 << 11) | 20) & 0xFu; }
#define XB_SPIN(cond, bar) do { unsigned _sp = 0; while (cond) { __builtin_amdgcn_s_sleep(1); \
    if ((++_sp & 255u) == 0u) { if (xb_ld(&(bar)[XB_TMO])) break; if (_sp > XB_SPIN_CAP) { atomicAdd(&(bar)[XB_TMO], 1u); break; } } } } while (0)

struct XcdBarrier {
    unsigned* bar; unsigned x;
    volatile LAS unsigned* st;
};

__device__ __forceinline__ XcdBarrier xcd_barrier_post(unsigned* bar, volatile LAS unsigned* st) {
    XcdBarrier b; b.bar = bar; b.x = xb_xcc_id(); b.st = st;
    if (threadIdx.x == 0) (void)xb_add(&bar[XB_XCNT(b.x)], 1u);
    return b;
}
__device__ __forceinline__ void xcd_barrier_complete(unsigned* bar, unsigned x, unsigned& nloc, unsigned& nx) {
    const unsigned G = gridDim.x * gridDim.y * gridDim.z;
    unsigned sum, cnt, mine, sp = 0u;
    for (;;) {
        sum = 0u; cnt = 0u; mine = 0u;
#pragma unroll
        for (unsigned j = 0; j < 16; ++j) { const unsigned c = xb_ld(&bar[XB_XCNT(j)]); sum += c; cnt += (c > 0u) ? 1u : 0u; mine = (j == x) ? c : mine; }
        if (sum == G) break;
        __builtin_amdgcn_s_sleep(1);
        if ((++sp & 255u) == 0u) { if (xb_ld(&bar[XB_TMO])) break; if (sp > XB_SPIN_CAP) { atomicAdd(&bar[XB_TMO], 1u); break; } }
    }
    nloc = mine > 0u ? mine : 1u; nx = cnt > 0u ? cnt : 1u;
}

__device__ __forceinline__ void xcd_barrier(const XcdBarrier& b) {
    asm volatile("s_waitcnt vmcnt(0)" ::: "memory");
    __syncthreads();
    if (threadIdx.x == 0) {
        unsigned* bar = b.bar;
        __builtin_amdgcn_s_waitcnt(0);
        unsigned nloc = b.st[0], nx = b.st[1];
        if (nloc == 0u) { xcd_barrier_complete(bar, b.x, nloc, nx); b.st[0] = nloc; b.st[1] = nx; }
        const unsigned old = xb_add(&bar[XB_XSUB(b.x)], 1u);
        const unsigned gen = old / nloc;
        if (old + 1u == (gen + 1u) * nloc) {
            __builtin_amdgcn_fence(__ATOMIC_RELEASE, "agent");
            asm volatile("s_waitcnt vmcnt(0)" ::: "memory");
            const unsigned og = xb_add(&bar[XB_TOP], 1u);
            const unsigned tg = og / nx;
            if (og + 1u == (tg + 1u) * nx) xb_add(&bar[XB_TOPGEN], 1u);
            else XB_SPIN(xb_ld(&bar[XB_TOPGEN]) == tg, bar);
            __builtin_amdgcn_fence(__ATOMIC_ACQUIRE, "agent");
            xb_add(&bar[XB_XGEN(b.x)], 1u);
            asm volatile("s_waitcnt vmcnt(0)" ::: "memory");
        } else {
            XB_SPIN(xb_ld(&bar[XB_XGEN(b.x)]) == gen, bar);
            __builtin_amdgcn_fence(__ATOMIC_ACQUIRE, "agent");
            asm volatile("s_waitcnt vmcnt(0)" ::: "memory");
        }
    }
    __syncthreads();
}

#ifndef NAIVE_ATTN
#define NAIVE_ATTN 0
#endif
constexpr int NWAVES = 8;
constexpr int DM = 2048, NPROJ = 7168, SEQ = 2048, NBATCH = 4, MP = NBATCH * SEQ  , MS = 32, MTOK = MP + MS  , MPAD = 8448, MMEM = 1024;
constexpr int WA = 768, WM = 512, NMEM = 256, PASTW = 2048;
constexpr float QSCALE = 0.12751743082459868f;
constexpr float DN_ALPHA = 1.189207115002721f;
constexpr float LN_EPS = 1e-5f, RMS_EPS = 1e-6f;
constexpr size_t OUT_Y = 0, OUT_YS = 16777216, OUT_KP = 16842752, OUT_VP = 23134208, OUT_SP = 29425664, OUT_MKP = 29818880, OUT_MVP = 30343168,
                 OUT_KS = 30867456, OUT_VS = 30892032, OUT_SS = 30916608, OUT_TOTAL = 34062336;
constexpr size_t MiB = 1u << 20;
constexpr size_t WS_CTL = 0, CTL_ZERO_BYTES = 1 * MiB;
constexpr size_t WS_LB = 1 * MiB;
constexpr size_t WS_COS = 2 * MiB, WS_SIN = 3 * MiB;
constexpr size_t WS_XB = 4 * MiB;
constexpr size_t WS_WT = 42 * MiB;
constexpr size_t WS_WOUTT = 74 * MiB;
constexpr size_t WS_QA = 82 * MiB, WS_KA = 95 * MiB, WS_VA = 108 * MiB, WS_GA = 121 * MiB;
constexpr size_t WS_QB = 134 * MiB, WS_KB = 147 * MiB, WS_VB = 160 * MiB, WS_GB = 173 * MiB;
constexpr size_t WS_LF = 186 * MiB;
constexpr size_t WS_QM = 211 * MiB, WS_GM = 220 * MiB;
constexpr size_t WS_MK = 229 * MiB, WS_MV = 230 * MiB;
constexpr size_t WS_Z = 231 * MiB;
constexpr size_t WS_OP = 264 * MiB;
constexpr size_t WS_LSE = 300 * MiB;
constexpr size_t WS_U = 301 * MiB, WS_SPV = 325 * MiB;
constexpr size_t WS_DC = 349 * MiB;
constexpr size_t WS_RS = 350 * MiB;
constexpr size_t WS_SAMP = 351 * MiB;
constexpr size_t WS_HO = 353 * MiB;
constexpr size_t WS_END = 384 * MiB;
constexpr int CW_BAR = 4096;
constexpr int RING_OFF = 0, RING_BYTES = 131072;
constexpr int LDSCTL_OFF = RING_BYTES, MISC_OFF = LDSCTL_OFF + 320;
constexpr int LDS_BYTES = 147456;

struct Args { const float* in[15]; float* out; unsigned char* ws; };

__device__ __forceinline__ float bf2f(unsigned h) { return __uint_as_float(h << 16); }
__device__ __forceinline__ float bflo(unsigned w) { return __uint_as_float(w << 16); }
__device__ __forceinline__ float bfhi(unsigned w) { return __uint_as_float(w & 0xffff0000u); }
__device__ __forceinline__ float wave_sum(float v) {
#pragma unroll
    for (int o = 1; o < 64; o <<= 1) v += __shfl_xor(v, o);
    return v;
}
__device__ __forceinline__ float sigmoidf_(float x) { return __builtin_amdgcn_rcpf(1.0f + __builtin_amdgcn_exp2f(-1.4426950408889634f * x)); }
__device__ __forceinline__ float siluf_(float x) { return x * sigmoidf_(x); }

namespace pg8 {
__host__ __device__ __forceinline__ int rowmap_win(int n) { if (n < 1536) { const int d = n & 127; return (n & ~127) + 8 * ((d & 63) >> 2) + 4 * (d >> 6) + (d & 3); } return n; }

struct EpiProj {
    static constexpr bool PERM = true, AFTER_DRAIN = false;
    unsigned char* ws; float* out;
    __device__ __forceinline__ void operator()(const f32x4 (&acc)[2][2][4][2], const Unit& u, int wr, int wc, int fr, int fq) const {
        const int pn = u.pn, pm = u.pm;
        int seg, colt;
        if (pn < 24) { seg = pn / 3; colt = (pn % 3) * 256; } else if (pn < 28) { seg = 8 + ((pn - 24) >> 1); colt = ((pn - 24) & 1) * 256; } else { seg = 10 + ((pn - 28) >> 1); colt = ((pn - 28) & 1) * 256; }
        const float* cosT = (const float*)(ws + WS_COS); const float* sinT = (const float*)(ws + WS_SIN); const float* LB = (const float*)(ws + WS_LB);
#pragma unroll
        for (int ai = 0; ai < 2; ++ai)
#pragma unroll
            for (int m = 0; m < 4; ++m) {
                const int row = pm * BM + ai * HALF + wr * 64 + m * 16 + fr;
#pragma unroll
                for (int bj = 0; bj < 2; ++bj) {
                    const int c0 = colt + bj * HALF + wc * 32 + 8 * fq;
                    f32x4 v0 = acc[ai][bj][m][0], v1 = acc[ai][bj][m][1];
                    if (seg >= 10) {
                        const int mr = row - MPAD;
                        float* o = out + (seg == 10 ? OUT_MKP : OUT_MVP) + (size_t)mr * WM + c0;
                        *(f32x4*)o = v0; *(f32x4*)(o + 4) = v1;
                        bf16_t* b = (bf16_t*)(ws + (seg == 10 ? WS_MK : WS_MV)) + (size_t)mr * WM + c0;
                        u32x4 w; w.x = cvt_pk_bf16(v0[0], v0[1]); w.y = cvt_pk_bf16(v0[2], v0[3]); w.z = cvt_pk_bf16(v1[0], v1[1]); w.w = cvt_pk_bf16(v1[2], v1[3]);
                        *(u32x4*)b = w;
                        continue;
                    }
                    if (seg <= 1) {
                        const int i0 = 4 * ((c0 & 127) >> 3);
                        const int pr = row < MP ? (row & (SEQ - 1)) : SEQ;
                        const f32x4 cs = *(const f32x4*)(cosT + pr * 64 + i0), sn = *(const f32x4*)(sinT + pr * 64 + i0);
                        const f32x4 o1 = v0 * cs - v1 * sn, o2 = v1 * cs + v0 * sn;
                        if (seg == 1) {
                            if (row < MTOK) {
                                float* o = (row < MP ? out + OUT_KP + (size_t)row * WA : out + OUT_KS + (size_t)(row - MP) * WA) + (c0 & ~127) + i0;
                                *(f32x4*)o = o1; *(f32x4*)(o + 64) = o2;
                            }
                            v0 = o1; v1 = o2;
                        } else { v0 = o1 * QSCALE; v1 = o2 * QSCALE; }
                    } else if (seg == 2) {
                        if (row < MTOK) {
                            float* o = (row < MP ? out + OUT_VP + (size_t)row * WA : out + OUT_VS + (size_t)(row - MP) * WA) + c0;
                            *(f32x4*)o = v0; *(f32x4*)(o + 4) = v1;
                        }
                    } else if (seg == 3 || seg == 7 || seg == 9) {
#pragma unroll
                        for (int e = 0; e < 4; ++e) { v0[e] = siluf_(v0[e]); v1[e] = siluf_(v1[e]); }
                    } else if (seg == 5) {
                        const f32x4 la = *(const f32x4*)(LB + c0), lb = *(const f32x4*)(LB + c0 + 4);
                        f32x4 l0, l1;
#pragma unroll
                        for (int e = 0; e < 4; ++e) {
                            const float sa = sigmoidf_(v0[e]), sb = sigmoidf_(v1[e]);
                            const float fa = la[e] + (1.0f - la[e]) * sa, fb = lb[e] + (1.0f - lb[e]) * sb;
                            l0[e] = __logf(fa); l1[e] = __logf(fb);
                            v0[e] = (1.0f - la[e]) * (1.0f - sa); v1[e] = (1.0f - lb[e]) * (1.0f - sb);
                        }
                        float* lf = (float*)(ws + WS_LF) + (size_t)row * WA + c0;
                        *(f32x4*)lf = l0; *(f32x4*)(lf + 4) = l1;
                    } else if (seg == 8) { v0 = v0 * QSCALE; v1 = v1 * QSCALE; }
                    size_t boff; int ld;
                    if (seg < 8) { boff = WS_QA + (size_t)seg * 13 * MiB; ld = WA; } else { boff = (seg == 8 ? WS_QM : WS_GM); ld = WM; }
                    bf16_t* b = (bf16_t*)(ws + boff) + (size_t)row * ld + c0;
                    u32x4 w; w.x = cvt_pk_bf16(v0[0], v0[1]); w.y = cvt_pk_bf16(v0[2], v0[3]); w.z = cvt_pk_bf16(v1[0], v1[1]); w.w = cvt_pk_bf16(v1[2], v1[3]);
                    *(u32x4*)b = w;
                }
            }
    }
};
static_assert(WS_KA == WS_QA + 13 * MiB && WS_VA == WS_QA + 26 * MiB && WS_GA == WS_QA + 39 * MiB && WS_QB == WS_QA + 52 * MiB && WS_KB == WS_QA + 65 * MiB && WS_VB == WS_QA + 78 * MiB && WS_GB == WS_QA + 91 * MiB, "segment buffers 13 MiB apart");

struct SchedProj {
    int G, c;
    __device__ __forceinline__ bool next(int i, Unit& u) const {
        const int L = i * G + c; constexpr int nM = 33, nN = 28, nwg = nM * nN;
        if (L >= nwg + 16) return false;
        if (L >= nwg) { const int j = L - nwg; u.pm = nM + (j >> 2); u.pn = nN + (j & 3); return true; }
        int wgid = L; { const int q = nwg / NXCD, r = nwg % NXCD, xcd = wgid % NXCD, off = wgid / NXCD; wgid = (xcd < r ? xcd * (q + 1) : r * (q + 1) + (xcd - r) * q) + off; }
        const int nig = WGM * nN, gid = wgid / nig, fm = gid * WGM, gsz = (nM - fm) < WGM ? (nM - fm) : WGM;
        u.pm = fm + ((wgid % nig) % gsz); u.pn = (wgid % nig) / gsz; return true;
    }
    __device__ __forceinline__ void a_ready(const Unit&) const {}
    __device__ __forceinline__ void done(const Unit&) const {}
};

struct EpiRes {
    static constexpr bool PERM = false, AFTER_DRAIN = false;
    const float* x; float* out;
    __device__ __forceinline__ void operator()(const f32x4 (&acc)[2][2][4][2], const Unit& u, int wr, int wc, int fr, int fq) const {
#pragma unroll
        for (int ai = 0; ai < 2; ++ai)
#pragma unroll
            for (int m = 0; m < 4; ++m) {
                const size_t ro = (size_t)(u.pm * BM + ai * HALF + wr * 64 + m * 16 + fr) * DM;
#pragma unroll
                for (int bj = 0; bj < 2; ++bj)
#pragma unroll
                    for (int n = 0; n < 2; ++n) {
                        const int col = u.pn * BM + bj * HALF + wc * 32 + n * 16 + 4 * fq;
                        const f32x4 xv = *(const f32x4*)(x + ro + col);
                        *(f32x4*)(out + ro + col) = acc[ai][bj][m][n] + xv * DN_ALPHA;
                    }
            }
    }
};
}

struct Frame {
    LAS unsigned char* lds;
    int tid, lane, wave, vcu, G, gw, NGW;
    unsigned char* ws; float* out;
    const float* in[15];
};

template <bool PERMROWS>
__device__ __forceinline__ void p0_transpose_item(const float* W, int K, int N, bf16* WT, int row_off, LAS float* scr, int item, int lane) {
    const int nblk = N / 32, kb = item / nblk, nb = item % nblk, k0 = 64 * kb, n0 = 32 * nb;
#pragma unroll 8
    for (int i = 0; i < 32; ++i) { const int kk = 2 * i + (lane >> 5); scr[kk * 33 + (lane & 31)] = W[(size_t)(k0 + kk) * N + n0 + (lane & 31)]; }
    LDS_WAIT(); asm volatile("" ::: "memory");
    const int c = lane & 7;
#pragma unroll
    for (int j = 0; j < 4; ++j) { const int n = (lane >> 3) + 8 * j; const LAS float* s = scr + (8 * c) * 33 + n;
        v4u o; o.x = pk2(s[0 * 33], s[1 * 33]); o.y = pk2(s[2 * 33], s[3 * 33]); o.z = pk2(s[4 * 33], s[5 * 33]); o.w = pk2(s[6 * 33], s[7 * 33]);
        const int drow = row_off + (PERMROWS ? pg8::rowmap_win(n0 + n) : n0 + n);
        *(GAS v4u*)(WT + (size_t)drow * K + k0 + 8 * c) = o; }
    LDS_WAIT(); asm volatile("" ::: "memory");
}
__device__ __forceinline__ void p0_prologue(Frame& F) {
    LAS float* scr = (LAS float*)(F.lds + RING_OFF + F.wave * 16384);
    const float* w_in = F.in[8]; const float* w_mem = F.in[9]; const float* w_out = F.in[12];
    bf16* WT = (bf16*)(F.ws + WS_WT); bf16* WOT = (bf16*)(F.ws + WS_WOUTT); bf16* XB = (bf16*)(F.ws + WS_XB);
    constexpr int I_IN = (DM / 64) * (NPROJ / 32), I_MEM = (DM / 64) * (1024 / 32), I_OUT = (DM / 64) * (DM / 32);
    for (int it = F.gw; it < I_IN + I_MEM + I_OUT; it += F.NGW) {
        int r = it;
        if (r < I_IN) { p0_transpose_item<true>(w_in, DM, NPROJ, WT, 0, scr, r, F.lane); continue; } r -= I_IN;
        if (r < I_MEM) { p0_transpose_item<false>(w_mem, DM, 1024, WT, NPROJ, scr, r, F.lane); continue; } r -= I_MEM;
        p0_transpose_item<false>(w_out, DM, DM, WOT, 0, scr, r, F.lane);
    }
    for (int m = F.gw; m < MPAD + MMEM; m += F.NGW) {
        GAS unsigned long long* o8 = (GAS unsigned long long*)(XB + (size_t)m * DM) + F.lane;
        if (m >= MTOK && m < MPAD) {
#pragma unroll
            for (int j = 0; j < 8; ++j) o8[64 * j] = 0ull;
            continue;
        }
        const float* src = m < MP ? F.in[0] + (size_t)m * DM : (m < MTOK ? F.in[1] + (size_t)(m - MP) * DM : F.in[7] + (size_t)(m - MPAD) * DM);
        const GAS f32x4* xr = (const GAS f32x4*)src + F.lane;
        f32x4 v[8];
#pragma unroll
        for (int j = 0; j < 8; ++j) v[j] = xr[64 * j];
#pragma unroll
        for (int j = 0; j < 8; ++j) o8[64 * j] = (unsigned long long)pk2(v[j].x, v[j].y) | ((unsigned long long)pk2(v[j].z, v[j].w) << 32);
    }
    {
        float* cosT = (float*)(F.ws + WS_COS); float* sinT = (float*)(F.ws + WS_SIN);
        const int gt = F.gw * 64 + F.lane, NT = F.NGW * 64;
        for (int e = gt; e < (SEQ + 1) * 64; e += NT) {
            const int pr = e >> 6, i = e & 63; const double pos = pr < SEQ ? (double)pr : 8192.0;
            double inv = 1.0; for (int k = 0; k < i; ++k) inv *= 0.8659643233600653;
            const double ang = pos * inv; const double kq = __builtin_floor(ang * 0.15915494309189535); const float red = (float)(ang - kq * 6.283185307179586);
            cosT[e] = cosf(red); sinT[e] = sinf(red);
        }
        float* LB = (float*)(F.ws + WS_LB); const float* raw = F.in[10];
        for (int e = gt; e < WA; e += NT) LB[e] = 1.0f / (1.0f + expf(raw[WA + e] - raw[e]));
    }
}

struct SM { float m, l, a0, a1; };
__device__ __forceinline__ void sm_step(SM& s, float sc, float v0, float v1) {
    const float mn = fmaxf(s.m, sc), f = __builtin_amdgcn_exp2f(s.m - mn), p = __builtin_amdgcn_exp2f(sc - mn);
    s.l = s.l * f + p; s.a0 = s.a0 * f + p * v0; s.a1 = s.a1 * f + p * v1; s.m = mn;
}
__device__ __forceinline__ void naive_attn_task(Frame& F, int task) {
    const int lane = F.lane; const bf16* QA = (const bf16*)(F.ws + WS_QA); const bf16* KA = (const bf16*)(F.ws + WS_KA); const bf16* VA = (const bf16*)(F.ws + WS_VA); const bf16* GA = (const bf16*)(F.ws + WS_GA);
    bf16* Z = (bf16*)(F.ws + WS_Z);
    const int r = task / 6, h = task % 6;
    SM s{-1e30f, 0.f, 0.f, 0.f};
    if (r < MP) {
        const int t = r & (SEQ - 1);
        const unsigned qq = *(const unsigned*)(QA + (size_t)r * WA + h * 128 + 2 * lane); const float q0 = bflo(qq), q1 = bfhi(qq);
        for (int br = 0; br < 3; ++br) {
            const int dil = br == 0 ? 1 : (br == 1 ? 4 : 16); int cnt = t / dil; cnt = (cnt < 128 ? cnt : 128) + 1;
            for (int j = 0; j < cnt; ++j) {
                const size_t ko = (size_t)(r - j * dil) * WA + h * 128 + 2 * lane;
                const unsigned kk = *(const unsigned*)(KA + ko), vv = *(const unsigned*)(VA + ko);
                const float sc = wave_sum(q0 * bflo(kk) + q1 * bfhi(kk));
                sm_step(s, sc, bflo(vv), bfhi(vv));
            }
        }
    } else {
        const int bs = r - MP; const int p = 8 * (((2 * lane) & 63) >> 2) + 4 * (lane >> 5) + ((2 * lane) & 3);
        const unsigned qq = *(const unsigned*)(QA + (size_t)r * WA + h * 128 + p); const float q0 = bflo(qq), q1 = bfhi(qq);
        const float* ck = F.in[2]; const float* cv = F.in[3];
        const float2 kn = *(const float2*)(F.out + OUT_KS + (size_t)bs * WA + h * 128 + 2 * lane), vn = *(const float2*)(F.out + OUT_VS + (size_t)bs * WA + h * 128 + 2 * lane);
        const float scn = wave_sum(q0 * kn.x + q1 * kn.y);
        for (int br = 0; br < 3; ++br) {
            const int dil = br == 0 ? 1 : (br == 1 ? 4 : 16);
            sm_step(s, scn, vn.x, vn.y);
            for (int j = 1; j <= 128; ++j) {
                const size_t ko = ((size_t)(bs * PASTW + PASTW - j * dil) * 6 + h) * 128 + 2 * lane;
                const float2 k2 = *(const float2*)(ck + ko), v2 = *(const float2*)(cv + ko);
                const float sc = wave_sum(q0 * k2.x + q1 * k2.y);
                sm_step(s, sc, v2.x, v2.y);
            }
        }
    }
    const float il = 1.0f / s.l; const unsigned gg = *(const unsigned*)(GA + (size_t)r * WA + h * 128 + 2 * lane);
    *(unsigned*)(Z + (size_t)r * DM + h * 128 + 2 * lane) = pk2(s.a0 * il * bflo(gg), s.a1 * il * bfhi(gg));
}
__device__ __forceinline__ void naive_mem_task(Frame& F, int task) {
    const int lane = F.lane; const bf16* QM = (const bf16*)(F.ws + WS_QM); const bf16* GM = (const bf16*)(F.ws + WS_GM); const bf16* MK = (const bf16*)(F.ws + WS_MK); const bf16* MV = (const bf16*)(F.ws + WS_MV);
    bf16* Z = (bf16*)(F.ws + WS_Z);
    const int r = task >> 2, h = task & 3;
    const unsigned qq = *(const unsigned*)(QM + (size_t)r * WM + h * 128 + 2 * lane); const float q0 = bflo(qq), q1 = bfhi(qq);
    SM s{-1e30f, 0.f, 0.f, 0.f};
    if (r < MP) {
        const int b = r >> 11;
        for (int m = 0; m < NMEM; ++m) {
            const size_t ko = (size_t)(b * NMEM + m) * WM + h * 128 + 2 * lane;
            const unsigned kk = *(const unsigned*)(MK + ko), vv = *(const unsigned*)(MV + ko);
            const float sc = wave_sum(q0 * bflo(kk) + q1 * bfhi(kk));
            sm_step(s, sc, bflo(vv), bfhi(vv));
        }
    } else {
        const int bs = r - MP; const float* ck = F.in[5]; const float* cv = F.in[6];
        for (int m = 0; m < NMEM; ++m) {
            const size_t ko = ((size_t)(bs * NMEM + m) * 4 + h) * 128 + 2 * lane;
            const float2 k2 = *(const float2*)(ck + ko), v2 = *(const float2*)(cv + ko);
            const float sc = wave_sum(q0 * k2.x + q1 * k2.y);
            sm_step(s, sc, v2.x, v2.y);
        }
    }
    const float il = 1.0f / s.l; const unsigned gg = *(const unsigned*)(GM + (size_t)r * WM + h * 128 + 2 * lane);
    *(unsigned*)(Z + (size_t)r * DM + 1536 + h * 128 + 2 * lane) = pk2(s.a0 * il * bflo(gg), s.a1 * il * bfhi(gg));
}
__device__ __forceinline__ void naive_hgrn_prompt_item(Frame& F, int item) {
    const int lane = F.lane; const int vb = item & 15, bh = item >> 4, h = bh % 6, b = bh / 6;
    const bf16* QB = (const bf16*)(F.ws + WS_QB); const bf16* KB = (const bf16*)(F.ws + WS_KB); const bf16* VB = (const bf16*)(F.ws + WS_VB); const float* LF = (const float*)(F.ws + WS_LF);
    float* HO = (float*)(F.ws + WS_HO);
    float S0[8], S1[8];
#pragma unroll
    for (int j = 0; j < 8; ++j) { S0[j] = 0.f; S1[j] = 0.f; }
    for (int t = 0; t < SEQ; ++t) {
        const size_t ro = (size_t)(b * SEQ + t) * WA + h * 128;
        const float qa = bf2f(QB[ro + lane]), qb = bf2f(QB[ro + lane + 64]), ka = bf2f(KB[ro + lane]), kb = bf2f(KB[ro + lane + 64]);
        const float fa = __expf(LF[ro + lane]), fb = __expf(LF[ro + lane + 64]);
        const v4u vv = *(const v4u*)(VB + ro + vb * 8);
        float v[8] = {bflo(vv.x), bfhi(vv.x), bflo(vv.y), bfhi(vv.y), bflo(vv.z), bfhi(vv.z), bflo(vv.w), bfhi(vv.w)};
        float o[8];
#pragma unroll
        for (int j = 0; j < 8; ++j) { S0[j] = fa * S0[j] + ka * v[j]; S1[j] = fb * S1[j] + kb * v[j]; o[j] = wave_sum(qa * S0[j] + qb * S1[j]); }
        if (lane == 0) { *(f32x4*)(HO + ro + vb * 8) = (f32x4){o[0], o[1], o[2], o[3]}; *(f32x4*)(HO + ro + vb * 8 + 4) = (f32x4){o[4], o[5], o[6], o[7]}; }
    }
    float* so = F.out + OUT_SP + ((size_t)bh * 128) * 128 + vb * 8;
    *(f32x4*)(so + (size_t)lane * 128) = (f32x4){S0[0], S0[1], S0[2], S0[3]}; *(f32x4*)(so + (size_t)lane * 128 + 4) = (f32x4){S0[4], S0[5], S0[6], S0[7]};
    *(f32x4*)(so + (size_t)(lane + 64) * 128) = (f32x4){S1[0], S1[1], S1[2], S1[3]}; *(f32x4*)(so + (size_t)(lane + 64) * 128 + 4) = (f32x4){S1[4], S1[5], S1[6], S1[7]};
}
__device__ __forceinline__ void hgrn_sample_item(Frame& F, int item) {
    const int lane = F.lane; const int kb = item & 7, bh = item >> 3, h = bh % 6, bs = bh / 6; const int r = MP + bs;
    const bf16* QB = (const bf16*)(F.ws + WS_QB); const bf16* KB = (const bf16*)(F.ws + WS_KB); const bf16* VB = (const bf16*)(F.ws + WS_VB); const float* LF = (const float*)(F.ws + WS_LF);
    const size_t ro = (size_t)r * WA + h * 128;
    const unsigned vv = *(const unsigned*)(VB + ro + 2 * lane); const float v0 = bflo(vv), v1 = bfhi(vv);
    const float* sp = F.in[4] + ((size_t)bh * 128 + kb * 16) * 128 + 2 * lane; float* sn = F.out + OUT_SS + ((size_t)bh * 128 + kb * 16) * 128 + 2 * lane;
    float o0 = 0.f, o1 = 0.f;
#pragma unroll 4
    for (int k = 0; k < 16; ++k) {
        const int kk = kb * 16 + k;
        const float q = bf2f(QB[ro + kk]), kf = bf2f(KB[ro + kk]), f = __expf(LF[ro + kk]);
        const float2 s = *(const float2*)(sp + (size_t)k * 128);
        const float n0 = f * s.x + kf * v0, n1 = f * s.y + kf * v1;
        *(float2*)(sn + (size_t)k * 128) = make_float2(n0, n1);
        o0 += q * n0; o1 += q * n1;
    }
    float* po = (float*)(F.ws + WS_SAMP) + ((size_t)bh * 8 + kb) * 128 + 2 * lane;
    *(float2*)po = make_float2(o0, o1);
}
__device__ __forceinline__ void hgrn_norm_task(Frame& F, int task) {
    const int lane = F.lane; const int r = task / 6, h = task % 6;
    const bf16* GB = (const bf16*)(F.ws + WS_GB); bf16* Z = (bf16*)(F.ws + WS_Z); const float* ng = F.in[11];
    float o0, o1;
    if (r < MP) { const float2 o = *(const float2*)((const float*)(F.ws + WS_HO) + (size_t)r * WA + h * 128 + 2 * lane); o0 = o.x; o1 = o.y; }
    else { const int bh = (r - MP) * 6 + h; o0 = 0.f; o1 = 0.f;
#pragma unroll
        for (int kb = 0; kb < 8; ++kb) { const float2 o = *(const float2*)((const float*)(F.ws + WS_SAMP) + ((size_t)bh * 8 + kb) * 128 + 2 * lane); o0 += o.x; o1 += o.y; } }
    const float ss = wave_sum(o0 * o0 + o1 * o1); const float rs = 1.0f / sqrtf(ss * (1.0f / 128.0f) + RMS_EPS);
    const unsigned gg = *(const unsigned*)(GB + (size_t)r * WA + h * 128 + 2 * lane); const float2 g2 = *(const float2*)(ng + h * 128 + 2 * lane);
    *(unsigned*)(Z + (size_t)r * DM + WA + h * 128 + 2 * lane) = pk2(o0 * rs * g2.x * bflo(gg), o1 * rs * g2.y * bfhi(gg));
}

__device__ __forceinline__ void sample_outproj(Frame& F) {
    const bf16* Z = (const bf16*)(F.ws + WS_Z); const bf16* WOT = (const bf16*)(F.ws + WS_WOUTT); float* RS = (float*)(F.ws + WS_RS);
    LAS float* red = (LAS float*)(F.lds + RING_OFF);
    for (int cb = F.vcu; cb < DM / 8; cb += F.G) {
        const int idx = F.tid & 255, half = F.tid >> 8, row = idx >> 3, col = cb * 8 + (idx & 7);
        const v4u* zp = (const v4u*)(Z + (size_t)(MP + row) * DM + half * 1024); const v4u* wp = (const v4u*)(WOT + (size_t)col * DM + half * 1024);
        float acc = 0.f;
        for (int k = 0; k < 128; ++k) { const v4u a = zp[k], b = wp[k];
            acc += bflo(a.x) * bflo(b.x) + bfhi(a.x) * bfhi(b.x) + bflo(a.y) * bflo(b.y) + bfhi(a.y) * bfhi(b.y) + bflo(a.z) * bflo(b.z) + bfhi(a.z) * bfhi(b.z) + bflo(a.w) * bflo(b.w) + bfhi(a.w) * bfhi(b.w); }
        __syncthreads();
        if (half == 1) red[idx] = acc;
        __syncthreads();
        if (half == 0) RS[(size_t)row * DM + col] = acc + red[idx] + DN_ALPHA * F.in[1][(size_t)row * DM + col];
    }
    __syncthreads();
}
__device__ __forceinline__ void ln_row(Frame& F, const float* rrow, float* orow) {
    const GAS f32x4* xr = (const GAS f32x4*)rrow + F.lane; const GAS f32x4* gp = (const GAS f32x4*)F.in[13] + F.lane; const GAS f32x4* bp = (const GAS f32x4*)F.in[14] + F.lane;
    f32x4 v[8]; float s = 0.f;
#pragma unroll
    for (int j = 0; j < 8; ++j) { v[j] = xr[64 * j]; s += (v[j].x + v[j].y) + (v[j].z + v[j].w); }
    const float mean = wave_sum(s) * (1.f / DM); float s2 = 0.f;
#pragma unroll
    for (int j = 0; j < 8; ++j) { v[j] = v[j] - mean; s2 += (v[j].x * v[j].x + v[j].y * v[j].y) + (v[j].z * v[j].z + v[j].w * v[j].w); }
    const float rstd = 1.f / sqrtf(wave_sum(s2) * (1.f / DM) + LN_EPS);
    GAS f32x4* op = (GAS f32x4*)orow + F.lane;
#pragma unroll
    for (int j = 0; j < 8; ++j) op[64 * j] = v[j] * rstd * gp[64 * j] + bp[64 * j];
}


typedef short v4i16_t __attribute__((ext_vector_type(4)));
typedef unsigned u32x2 __attribute__((ext_vector_type(2)));
typedef unsigned u32x4 __attribute__((ext_vector_type(4)));
__device__ __forceinline__ unsigned cvtpk(float lo, float hi) { unsigned r; asm volatile("v_cvt_pk_bf16_f32 %0, %1, %2" : "=v"(r) : "v"(lo), "v"(hi)); return r; }
__device__ __forceinline__ v4i16_t tr_read(LAS unsigned char* p) { return __builtin_amdgcn_ds_read_tr16_b64_v4i16((LAS v4i16_t*)p); }
constexpr float NEGBIG = -1e30f;
constexpr int ATT_K_OFF = 0, ATT_V_OFF = 65536;
template <bool BAND>
__device__ __forceinline__ void attn_unit(Frame& F, const bf16* kbase, const bf16* vbase, long kstride, int skip, const bf16* qbase, long qstride,
                                          bf16* obase, long ostride, float* lse, int lse_stride, const bf16* gate, long gstride) {
    constexpr int NT = BAND ? 9 : 16;
    LAS unsigned char* lds = F.lds + RING_OFF;
    const int w = F.wave, lane = F.lane, fr = lane & 15, fq = lane >> 4;
    if (skip) {
        for (int u = F.tid; u < skip * 16; u += NWAVES * 64) { *(LAS v4u*)(lds + ATT_K_OFF + u * 16) = (v4u){0u, 0u, 0u, 0u}; *(LAS v4u*)(lds + ATT_V_OFF + u * 16) = (v4u){0u, 0u, 0u, 0u}; }
    }
#pragma unroll
    for (int i = 0; i < 8; ++i) {
        const int R0 = 32 * i + 4 * w;
        if (R0 >= skip) {
            const int row = R0 + (lane >> 4), chp = lane & 15;
            const int ck = chp ^ (row & 15), cv = chp ^ (((row & 3) << 2) | (((row >> 2) & 1) << 1));
            __builtin_amdgcn_global_load_lds((const unsigned*)(kbase + (long)row * kstride + ck * 8), (LAS unsigned*)(lds + ATT_K_OFF + R0 * 256), 16, 0, 0);
            __builtin_amdgcn_global_load_lds((const unsigned*)(vbase + (long)row * kstride + cv * 8), (LAS unsigned*)(lds + ATT_V_OFF + R0 * 256), 16, 0, 0);
        }
    }
    bf16x8 qf[4];
    { const bf16* qr = qbase + (long)(16 * w + fr) * qstride + 8 * fq;
#pragma unroll
      for (int ks = 0; ks < 4; ++ks) qf[ks] = *(const bf16x8*)(qr + 32 * ks); }
    asm volatile("s_waitcnt vmcnt(0) lgkmcnt(0)" ::: "memory");
    __syncthreads();
    const int kt0 = BAND ? w : 0;
    f32x4 s[NT];
#pragma unroll
    for (int j = 0; j < NT; ++j) {
        s[j] = (f32x4){0.f, 0.f, 0.f, 0.f};
        LAS unsigned char* kp = lds + ATT_K_OFF + (16 * (kt0 + j) + fr) * 256;
#pragma unroll
        for (int ks = 0; ks < 4; ++ks) {
            const bf16x8 kf = *(const LAS bf16x8*)(kp + 16 * ((4 * ks + fq) ^ fr));
            s[j] = __builtin_amdgcn_mfma_f32_16x16x32_bf16(kf, qf[ks], s[j], 0, 0, 0);
        }
    }
    if (BAND) {
#pragma unroll
        for (int reg = 0; reg < 4; ++reg) { const int kap = 4 * fq + reg; if (kap < fr) s[0][reg] = NEGBIG; if (kap > fr) s[NT - 1][reg] = NEGBIG; }
        if (skip) {
#pragma unroll
            for (int j = 0; j < 8; ++j) if (kt0 + j < 8) s[j] = (f32x4){NEGBIG, NEGBIG, NEGBIG, NEGBIG};
        }
    }
    float mx = NEGBIG;
#pragma unroll
    for (int j = 0; j < NT; ++j) mx = fmaxf(fmaxf(mx, fmaxf(s[j][0], s[j][1])), fmaxf(s[j][2], s[j][3]));
    mx = fmaxf(mx, __shfl_xor(mx, 16)); mx = fmaxf(mx, __shfl_xor(mx, 32));
    float lsum = 0.f;
#pragma unroll
    for (int j = 0; j < NT; ++j)
#pragma unroll
        for (int reg = 0; reg < 4; ++reg) { const float p = __builtin_amdgcn_exp2f(s[j][reg] - mx); s[j][reg] = p; lsum += p; }
    lsum += __shfl_xor(lsum, 16); lsum += __shfl_xor(lsum, 32);
    f32x4 o[8];
#pragma unroll
    for (int dg = 0; dg < 8; ++dg) o[dg] = (f32x4){0.f, 0.f, 0.f, 0.f};
    const int qq = fr >> 2, pp = fr & 3, sg = (qq << 2) | ((fq & 1) << 1);
#pragma unroll
    for (int i = 0; i < (NT + 1) / 2; ++i) {
        u32x4 pb; pb.x = cvtpk(s[2 * i][0], s[2 * i][1]); pb.y = cvtpk(s[2 * i][2], s[2 * i][3]);
        if (2 * i + 1 < NT) { pb.z = cvtpk(s[2 * i + 1 < NT ? 2 * i + 1 : 0][0], s[2 * i + 1 < NT ? 2 * i + 1 : 0][1]); pb.w = cvtpk(s[2 * i + 1 < NT ? 2 * i + 1 : 0][2], s[2 * i + 1 < NT ? 2 * i + 1 : 0][3]); } else { pb.z = 0u; pb.w = 0u; }
        LAS unsigned char* vrow = lds + ATT_V_OFF + (16 * (kt0 + 2 * i) + 4 * fq + qq) * 256 + 8 * (pp & 1);
#pragma unroll
        for (int dg = 0; dg < 8; ++dg) {
            LAS unsigned char* va = vrow + 16 * ((2 * dg + (pp >> 1)) ^ sg);
            const v4i16_t lo = tr_read(va);
            v4i16_t hi = (v4i16_t){0, 0, 0, 0};
            if (2 * i + 1 < NT) hi = tr_read(va + 4096);
            const bf16x8 af = (bf16x8){lo[0], lo[1], lo[2], lo[3], hi[0], hi[1], hi[2], hi[3]};
            o[dg] = __builtin_amdgcn_mfma_f32_16x16x32_bf16(af, __builtin_bit_cast(bf16x8, pb), o[dg], 0, 0, 0);
        }
    }
    const float il = 1.0f / lsum; const int qi = 16 * w + fr;
    bf16* op = obase + (long)qi * ostride + 4 * fq;
    if (BAND) {
#pragma unroll
        for (int dg = 0; dg < 8; ++dg) { u32x2 w2; w2.x = cvtpk(o[dg][0] * il, o[dg][1] * il); w2.y = cvtpk(o[dg][2] * il, o[dg][3] * il); *(u32x2*)(op + 16 * dg) = w2; }
        if (fq == 0) lse[(long)qi * lse_stride] = mx + __log2f(lsum);
    } else {
        const bf16* gp = gate + (long)qi * gstride + 4 * fq;
#pragma unroll
        for (int dg = 0; dg < 8; ++dg) { const u32x2 g2 = *(const u32x2*)(gp + 16 * dg);
            u32x2 w2; w2.x = cvtpk(o[dg][0] * il * bflo(g2.x), o[dg][1] * il * bfhi(g2.x)); w2.y = cvtpk(o[dg][2] * il * bflo(g2.y), o[dg][3] * il * bfhi(g2.y)); *(u32x2*)(op + 16 * dg) = w2; }
    }
    __syncthreads();
}
__device__ __forceinline__ void attn_unit_dispatch(Frame& F, int u) {
    if (u < 256) {
        const int qb = u & 15, bh = u >> 4, h = bh & 3, b = bh >> 2;
        const bf16* MK = (const bf16*)(F.ws + WS_MK) + (size_t)(b * NMEM) * WM + h * 128; const bf16* MV = (const bf16*)(F.ws + WS_MV) + (size_t)(b * NMEM) * WM + h * 128;
        const size_t r0 = (size_t)b * SEQ + qb * 128;
        attn_unit<false>(F, MK, MV, WM, 0, (const bf16*)(F.ws + WS_QM) + r0 * WM + h * 128, WM, (bf16*)(F.ws + WS_Z) + r0 * DM + 1536 + h * 128, DM, nullptr, 0, (const bf16*)(F.ws + WS_GM) + r0 * WM + h * 128, WM);
    } else {
        const int v = u - 256, br = v / 384, rem = v % 384, cb = rem & 15, bh = rem >> 4, h = bh % 6, b = bh / 6;
        const int dil = br == 0 ? 1 : (br == 1 ? 4 : 16), nb = 16 / dil, cls = cb / nb, n = cb % nb;
        const long tok0 = (long)(128 * (n - 1)) * dil + cls;
        const bf16* kb = (const bf16*)(F.ws + WS_KA) + ((long)b * SEQ + tok0) * WA + h * 128; const bf16* vb = (const bf16*)(F.ws + WS_VA) + ((long)b * SEQ + tok0) * WA + h * 128;
        const long q0 = (long)b * SEQ + (long)(128 * n) * dil + cls;
        attn_unit<true>(F, kb, vb, (long)dil * WA, n == 0 ? 128 : 0, (const bf16*)(F.ws + WS_QA) + q0 * WA + h * 128, (long)dil * WA,
                        (bf16*)(F.ws + WS_OP) + ((size_t)br * MP + q0) * WA + h * 128, (long)dil * WA, (float*)(F.ws + WS_LSE) + ((size_t)br * MP + q0) * 6 + h, dil * 6, nullptr, 0);
    }
}
constexpr int PSTR = 132;
constexpr size_t SAMP_HG = 0, SAMP_AT = 1 * MiB, SAMP_ME = 1 * MiB + 512 * 1024;
__device__ __forceinline__ f32x4 load_q_true(const bf16* qhead, int li) { const u32x2 w = *(const u32x2*)(qhead + 8 * (li & 15) + 4 * (li >> 4)); return (f32x4){bflo(w.x), bfhi(w.x), bflo(w.y), bfhi(w.y)}; }
__device__ __forceinline__ f32x4 load_q_nat(const bf16* qhead, int li) { const u32x2 w = *(const u32x2*)(qhead + 4 * li); return (f32x4){bflo(w.x), bfhi(w.x), bflo(w.y), bfhi(w.y)}; }
__device__ __forceinline__ void decode_seq(const f32x4 q4, const float* kb, const float* vb, long stride, int nsteps, int lane, float* rec) {
    const int hl = lane >> 5, li = lane & 31;
    const float* kp = kb + hl * stride + 4 * li; const float* vp = vb + hl * stride + 4 * li;
    float m = NEGBIG, l = 0.f; f32x4 a = (f32x4){0.f, 0.f, 0.f, 0.f};
    for (int i = 0; i < nsteps; i += 4) {
        f32x4 k[4], v[4]; float sc[4];
#pragma unroll
        for (int u = 0; u < 4; ++u) { k[u] = *(const f32x4*)(kp + (long)(2 * (i + u)) * stride); v[u] = *(const f32x4*)(vp + (long)(2 * (i + u)) * stride); }
#pragma unroll
        for (int u = 0; u < 4; ++u) sc[u] = (q4[0] * k[u][0] + q4[1] * k[u][1]) + (q4[2] * k[u][2] + q4[3] * k[u][3]);
#pragma unroll
        for (int o = 1; o < 32; o <<= 1)
#pragma unroll
            for (int u = 0; u < 4; ++u) sc[u] += __shfl_xor(sc[u], o);
#pragma unroll
        for (int u = 0; u < 4; ++u) { const float mn = fmaxf(m, sc[u]), f = __builtin_amdgcn_exp2f(m - mn), p = __builtin_amdgcn_exp2f(sc[u] - mn); l = l * f + p; a = a * f + v[u] * p; m = mn; }
    }
    const float m2 = __shfl_xor(m, 32), l2 = __shfl_xor(l, 32);
    f32x4 a2; a2[0] = __shfl_xor(a[0], 32); a2[1] = __shfl_xor(a[1], 32); a2[2] = __shfl_xor(a[2], 32); a2[3] = __shfl_xor(a[3], 32);
    const float M = fmaxf(m, m2), f1 = __builtin_amdgcn_exp2f(m - M), f2 = __builtin_amdgcn_exp2f(m2 - M);
    if (hl == 0) { *(f32x4*)(rec + 4 + 4 * li) = a * f1 + a2 * f2; if (li == 0) { rec[0] = M; rec[1] = l * f1 + l2 * f2; } }
}
__device__ __forceinline__ void sample_attn_task(Frame& F, int task) {
    const int br = task % 3, bh = task / 3, h = bh % 6, bs = bh / 6; const int dil = br == 0 ? 1 : (br == 1 ? 4 : 16);
    const f32x4 q4 = load_q_true((const bf16*)(F.ws + WS_QA) + (size_t)(MP + bs) * WA + h * 128, F.lane & 31);
    const size_t o1 = ((size_t)(bs * PASTW + PASTW - dil) * 6 + h) * 128;
    decode_seq(q4, F.in[2] + o1, F.in[3] + o1, -(long)dil * WA, 64, F.lane, (float*)(F.ws + WS_SAMP + SAMP_AT) + (size_t)task * PSTR);
}
__device__ __forceinline__ void sample_mem_task(Frame& F, int task) {
    const int half = task & 1, bh = task >> 1, h = bh & 3, bs = bh >> 2;
    const f32x4 q4 = load_q_nat((const bf16*)(F.ws + WS_QM) + (size_t)(MP + bs) * WM + h * 128, F.lane & 31);
    const size_t o1 = ((size_t)(bs * NMEM + half * 128) * 4 + h) * 128;
    decode_seq(q4, F.in[5] + o1, F.in[6] + o1, 512, 64, F.lane, (float*)(F.ws + WS_SAMP + SAMP_ME) + (size_t)task * PSTR);
}
__device__ __forceinline__ void merge_prompt_attn(Frame& F) {
    const bf16* OP = (const bf16*)(F.ws + WS_OP); const float* LSE = (const float*)(F.ws + WS_LSE); const bf16* GA = (const bf16*)(F.ws + WS_GA); bf16* Z = (bf16*)(F.ws + WS_Z);
    const int gt = F.gw * 64 + F.lane, NTH = F.NGW * 64;
    for (int idx = gt; idx < MP * 96; idx += NTH) {
        const int r = idx / 96, c8 = idx % 96, h = c8 >> 4;
        const float l0 = LSE[(size_t)r * 6 + h], l1 = LSE[((size_t)MP + r) * 6 + h], l2 = LSE[((size_t)2 * MP + r) * 6 + h];
        const float M = fmaxf(l0, fmaxf(l1, l2)); float w0 = __builtin_amdgcn_exp2f(l0 - M), w1 = __builtin_amdgcn_exp2f(l1 - M), w2 = __builtin_amdgcn_exp2f(l2 - M);
        const float inv = 1.0f / (w0 + w1 + w2); w0 *= inv; w1 *= inv; w2 *= inv;
        const size_t off = (size_t)r * WA + c8 * 8;
        const v4u a = *(const v4u*)(OP + off), b = *(const v4u*)(OP + (size_t)MP * WA + off), c = *(const v4u*)(OP + (size_t)2 * MP * WA + off), g = *(const v4u*)(GA + off);
        v4u o;
        o.x = pk2((w0 * bflo(a.x) + w1 * bflo(b.x) + w2 * bflo(c.x)) * bflo(g.x), (w0 * bfhi(a.x) + w1 * bfhi(b.x) + w2 * bfhi(c.x)) * bfhi(g.x));
        o.y = pk2((w0 * bflo(a.y) + w1 * bflo(b.y) + w2 * bflo(c.y)) * bflo(g.y), (w0 * bfhi(a.y) + w1 * bfhi(b.y) + w2 * bfhi(c.y)) * bfhi(g.y));
        o.z = pk2((w0 * bflo(a.z) + w1 * bflo(b.z) + w2 * bflo(c.z)) * bflo(g.z), (w0 * bfhi(a.z) + w1 * bfhi(b.z) + w2 * bfhi(c.z)) * bfhi(g.z));
        o.w = pk2((w0 * bflo(a.w) + w1 * bflo(b.w) + w2 * bflo(c.w)) * bflo(g.w), (w0 * bfhi(a.w) + w1 * bfhi(b.w) + w2 * bfhi(c.w)) * bfhi(g.w));
        *(v4u*)(Z + (size_t)r * DM + c8 * 8) = o;
    }
}
__device__ __forceinline__ void merge_sample_task(Frame& F, int task) {
    const int lane = F.lane, li = lane & 31; const int bs = task / 10, hh = task % 10; const int r = MP + bs;
    bf16* Z = (bf16*)(F.ws + WS_Z);
    if (hh < 6) {
        const int h = hh;
        const f32x4 q4 = load_q_true((const bf16*)(F.ws + WS_QA) + (size_t)r * WA + h * 128, li);
        const f32x4 kn = *(const f32x4*)(F.out + OUT_KS + (size_t)bs * WA + h * 128 + 4 * li), vn = *(const f32x4*)(F.out + OUT_VS + (size_t)bs * WA + h * 128 + 4 * li);
        float sn = (q4[0] * kn[0] + q4[1] * kn[1]) + (q4[2] * kn[2] + q4[3] * kn[3]);
#pragma unroll
        for (int o = 1; o < 32; o <<= 1) sn += __shfl_xor(sn, o);
        const float* rec = (const float*)(F.ws + WS_SAMP + SAMP_AT) + (size_t)((bs * 6 + h) * 3) * PSTR;
        const float m0 = rec[0], m1 = rec[PSTR], m2 = rec[2 * PSTR]; const float M = fmaxf(fmaxf(m0, m1), fmaxf(m2, sn));
        const float f0 = __builtin_amdgcn_exp2f(m0 - M), f1 = __builtin_amdgcn_exp2f(m1 - M), f2 = __builtin_amdgcn_exp2f(m2 - M), fn = 3.0f * __builtin_amdgcn_exp2f(sn - M);
        const float L = rec[1] * f0 + rec[PSTR + 1] * f1 + rec[2 * PSTR + 1] * f2 + fn;
        const f32x4 a = *(const f32x4*)(rec + 4 + 4 * li) * f0 + *(const f32x4*)(rec + PSTR + 4 + 4 * li) * f1 + *(const f32x4*)(rec + 2 * PSTR + 4 + 4 * li) * f2 + vn * fn;
        const float il = 1.0f / L; const u32x2 g = *(const u32x2*)((const bf16*)(F.ws + WS_GA) + (size_t)r * WA + h * 128 + 4 * li);
        if (lane < 32) { u32x2 o; o.x = pk2(a[0] * il * bflo(g.x), a[1] * il * bfhi(g.x)); o.y = pk2(a[2] * il * bflo(g.y), a[3] * il * bfhi(g.y)); *(u32x2*)(Z + (size_t)r * DM + h * 128 + 4 * li) = o; }
    } else {
        const int h = hh - 6;
        const float* rec = (const float*)(F.ws + WS_SAMP + SAMP_ME) + (size_t)((bs * 4 + h) * 2) * PSTR;
        const float m0 = rec[0], m1 = rec[PSTR]; const float M = fmaxf(m0, m1); const float f0 = __builtin_amdgcn_exp2f(m0 - M), f1 = __builtin_amdgcn_exp2f(m1 - M);
        const float L = rec[1] * f0 + rec[PSTR + 1] * f1;
        const f32x4 a = *(const f32x4*)(rec + 4 + 4 * li) * f0 + *(const f32x4*)(rec + PSTR + 4 + 4 * li) * f1;
        const float il = 1.0f / L; const u32x2 g = *(const u32x2*)((const bf16*)(F.ws + WS_GM) + (size_t)r * WM + h * 128 + 4 * li);
        if (lane < 32) { u32x2 o; o.x = pk2(a[0] * il * bflo(g.x), a[1] * il * bfhi(g.x)); o.y = pk2(a[2] * il * bflo(g.y), a[3] * il * bfhi(g.y)); *(u32x2*)(Z + (size_t)r * DM + 1536 + h * 128 + 4 * li) = o; }
    }
}

__global__ void __launch_bounds__(NWAVES * 64, 2) fwd_kernel(Args args) {
    extern __shared__ __attribute__((aligned(16))) unsigned char lds[];
    Frame F;
    F.lds = (LAS unsigned char*)lds;
    F.tid = threadIdx.x; F.lane = F.tid & 63; F.wave = __builtin_amdgcn_readfirstlane(F.tid >> 6);
    F.G = gridDim.x; { const int bx = blockIdx.x; F.vcu = (F.G % 8 == 0) ? (bx % 8) * (F.G / 8) + bx / 8 : bx; }
    F.gw = F.vcu * NWAVES + F.wave; F.NGW = F.G * NWAVES;
    F.ws = args.ws; F.out = args.out;
#pragma unroll
    for (int i = 0; i < 15; ++i) F.in[i] = args.in[i];
    gu32* ctl = (gu32*)(F.ws + WS_CTL);
    volatile LAS unsigned* MISC = (volatile LAS unsigned*)(F.lds + MISC_OFF);
    for (int u = F.tid; u < (LDS_BYTES - LDSCTL_OFF) / 4; u += NWAVES * 64) ((LAS unsigned*)(F.lds + LDSCTL_OFF))[u] = 0u;
    __syncthreads();
    XcdBarrier bar = xcd_barrier_post((unsigned*)(ctl + CW_BAR), MISC + 8);

    p0_prologue(F);
    xcd_barrier(bar);
    {
        pg8::Gemm g{(const pg8::bf16_t*)(F.ws + WS_XB), (const pg8::bf16_t*)(F.ws + WS_WT), MPAD + MMEM, NPROJ + 1024, DM};
        pg8::SchedProj S{F.G, (int)blockIdx.x};
        pg8::EpiProj E{F.ws, F.out};
        pg8::gemm_phase<pg8::EpiProj, pg8::SchedProj, true, true>(F.lds + RING_OFF, g, S, E);
    }
    xcd_barrier(bar);
    {
#if NAIVE_ATTN
        constexpr int N_HP = NBATCH * 6 * 16, N_HS = MS * 6 * 8, N_AT = MTOK * 6, N_ME = MTOK * 4;
        for (int it = F.gw; it < N_HP + N_HS + N_AT + N_ME; it += F.NGW) {
            int r = it;
            if (r < N_HP) { naive_hgrn_prompt_item(F, r); continue; } r -= N_HP;
            if (r < N_HS) { hgrn_sample_item(F, r); continue; } r -= N_HS;
            if (r < N_AT) { naive_attn_task(F, r); continue; } r -= N_AT;
            naive_mem_task(F, r);
        }
#else
        constexpr int N_HP = NBATCH * 6 * 16, N_HS = MS * 6 * 8, N_SA = MS * 6 * 3, N_SM = MS * 4 * 2;
        for (int it = F.gw; it < N_HP + N_HS + N_SA + N_SM; it += F.NGW) {
            int r = it;
            if (r < N_HP) { naive_hgrn_prompt_item(F, r); continue; } r -= N_HP;
            if (r < N_HS) { hgrn_sample_item(F, r); continue; } r -= N_HS;
            if (r < N_SA) { sample_attn_task(F, r); continue; } r -= N_SA;
            sample_mem_task(F, r);
        }
        __syncthreads();
        for (int u = F.vcu; u < 1408; u += F.G) attn_unit_dispatch(F, u);
#endif
    }
    xcd_barrier(bar);
    for (int it = F.gw; it < MTOK * 6; it += F.NGW) hgrn_norm_task(F, it);
#if !NAIVE_ATTN
    merge_prompt_attn(F);
    for (int it = F.gw; it < MS * 10; it += F.NGW) merge_sample_task(F, it);
#endif
    xcd_barrier(bar);
    {
        sample_outproj(F);
        pg8::Gemm g{(const pg8::bf16_t*)(F.ws + WS_Z), (const pg8::bf16_t*)(F.ws + WS_WOUTT), MP, DM, DM};
        pg8::StaticOrder S; S.init(MP, DM, F.G, (int)blockIdx.x);
        pg8::EpiRes E{F.in[0], F.out + OUT_Y};
        pg8::gemm_phase<pg8::EpiRes, pg8::StaticOrder, true, true>(F.lds + RING_OFF, g, S, E);
    }
    xcd_barrier(bar);
    for (int m = F.gw; m < MTOK; m += F.NGW) {
        if (m < MP) ln_row(F, F.out + OUT_Y + (size_t)m * DM, F.out + OUT_Y + (size_t)m * DM);
        else ln_row(F, (const float*)(F.ws + WS_RS) + (size_t)(m - MP) * DM, F.out + OUT_YS + (size_t)(m - MP) * DM);
    }
}

extern "C" void kernel_launch(void* const* d_in, const int* in_sizes, int n_in, void* d_out, int out_size, void* d_ws, size_t ws_size, hipStream_t stream) {
    static int grid = 0;
    if (grid == 0) {
        if (n_in != 15 || out_size != (int)OUT_TOTAL || ws_size < WS_END) { fprintf(stderr, "kernel_launch: unexpected shapes (n_in %d out %d ws %zu)\n", n_in, out_size, ws_size); grid = -1; return; }
        int dev = 0, cus = 0, per_cu = 0;
        if (hipGetDevice(&dev) != hipSuccess || hipDeviceGetAttribute(&cus, hipDeviceAttributeMultiprocessorCount, dev) != hipSuccess) { grid = -1; return; }
        if (hipFuncSetAttribute((const void*)fwd_kernel, hipFuncAttributeMaxDynamicSharedMemorySize, LDS_BYTES) != hipSuccess) { fprintf(stderr, "kernel_launch: hipFuncSetAttribute failed\n"); grid = -1; return; }
        if (hipOccupancyMaxActiveBlocksPerMultiprocessor(&per_cu, (const void*)fwd_kernel, NWAVES * 64, LDS_BYTES) != hipSuccess || per_cu < 1) { fprintf(stderr, "kernel_launch: occupancy query says %d blocks per CU\n", per_cu); per_cu = 1; }
        (void)hipGetLastError();
        grid = cus;
    }
    if (grid < 0) return;
    if (hipMemsetAsync((char*)d_ws + WS_CTL, 0, CTL_ZERO_BYTES, stream) != hipSuccess) { fprintf(stderr, "kernel_launch: memset failed\n"); return; }
    Args a{};
    for (int i = 0; i < 15; ++i) a.in[i] = (const float*)d_in[i];
    a.out = (float*)d_out; a.ws = (unsigned char*)d_ws;
    hipLaunchKernelGGL(fwd_kernel, dim3(grid), dim3(NWAVES * 64), LDS_BYTES, stream, a);
}
```

```cpp
#include <hip/hip_runtime.h>
#include <cstdio>
#include <cstdint>
#include <hip/hip_runtime.h>
#include <cstdio>
#include <cstdint>
namespace pg8 {
#define PG8_LAS __attribute__((address_space(3)))
typedef unsigned short bf16_t;
typedef short bf16x8 __attribute__((ext_vector_type(8)));
typedef float f32x4 __attribute__((ext_vector_type(4)));
typedef unsigned u32x4 __attribute__((ext_vector_type(4)));
constexpr int BM = 256, BK = 64, HALF = 128, HTB = HALF * BK * 2  , STAGE_BYTES = 8 * HTB, NXCD = 8, WGM = 8;

__host__ __device__ __forceinline__ int lds_byte(int r, int c) { const int st = (r >> 4) * 2 + (c >> 5), rr = r & 15, cc = c & 31, ob = rr * 64 + cc * 2; return st * 1024 + (ob ^ (((ob >> 9) & 1) << 5)); }
__host__ __device__ __forceinline__ void stage_rc(int b, int& R, int& C) { const int st = b / 1024, sb = b % 1024, swz = sb ^ (((sb >> 9) & 1) << 5); R = (st >> 1) * 16 + swz / 64; C = (st & 1) * 32 + (swz % 64) / 2; }
__host__ __device__ __forceinline__ int perm32(int rho) { const int n = rho >> 4, i = rho & 15; return 8 * (i >> 2) + 4 * n + (i & 3); }

struct Unit { int pm, pn; };
struct Gemm { const bf16_t* A; const bf16_t* Bt; int M, N, K; };

struct StaticOrder {
    int nM, nN, nwg, G, c;
    __host__ __device__ void init(int M, int N, int G_, int c_) { nM = M / BM; nN = N / BM; nwg = nM * nN; G = G_; c = c_; }
    __host__ __device__ bool next(int i, Unit& u) const {
        const long L = (long)i * G + c; if (L >= nwg) return false;
        int wgid = (int)L; { const int q = nwg / NXCD, r = nwg % NXCD, xcd = wgid % NXCD, off = wgid / NXCD; wgid = (xcd < r ? xcd * (q + 1) : r * (q + 1) + (xcd - r) * q) + off; }
        const int nig = WGM * nN, gid = wgid / nig, fm = gid * WGM, gsz = (nM - fm) < WGM ? (nM - fm) : WGM;
        u.pm = fm + ((wgid % nig) % gsz); u.pn = (wgid % nig) / gsz; return true;
    }
    __device__ __forceinline__ void a_ready(const Unit&) const {}
    __device__ __forceinline__ void done(const Unit&) const {}
};

__device__ __forceinline__ unsigned cvt_pk_bf16(float lo, float hi) { unsigned r; asm volatile("v_cvt_pk_bf16_f32 %0, %1, %2" : "=v"(r) : "v"(lo), "v"(hi)); return r; }
typedef float f32x2 __attribute__((ext_vector_type(2)));
__device__ __forceinline__ f32x2 gelu_pk(f32x2 v) {
    const f32x2 av = __builtin_elementwise_abs(v), d = av * 0.2316418882f + 1.0f;
    f32x2 t; t.x = __builtin_amdgcn_rcpf(d.x); t.y = __builtin_amdgcn_rcpf(d.y);
    f32x2 q = t * 0.5307027145f + (-0.7265760135f); q = q * t + 0.7107068705f; q = q * t + (-0.142248368f); q = q * t + 0.127414796f; q = q * t;
    const f32x2 s = (v * v) * (-0.72134752044f);
    f32x2 e; e.x = __builtin_amdgcn_exp2f(s.x); e.y = __builtin_amdgcn_exp2f(s.y);
    const f32x2 m = v * (q * e), r = v - m;
    f32x2 o; o.x = v.x < 0.f ? m.x : r.x; o.y = v.y < 0.f ? m.y : r.y; return o;
}

template <int ACT  > struct EpiBf16 {
    static constexpr bool PERM = true, AFTER_DRAIN = false; static_assert(ACT == 0 || ACT == 1, "EpiBf16: ACT is 0 (none) or 1 (gelu_pk)");
    bf16_t* O; int ldc; const float* bias; int split_cols; size_t split_stride; float scale0;
    __device__ __forceinline__ void operator()(const f32x4 (&acc)[2][2][4][2], const Unit& u, int wr, int wc, int fr, int fq) const {
        const int row0 = u.pm * BM + wr * 64 + fr; int colt = u.pn * BM; bf16_t* base = O;
        float sc = 1.f; if (split_cols) { const int t = colt / split_cols; base += (size_t)t * split_stride; colt -= t * split_cols; if (t == 0) sc = scale0; }
        const int col0 = colt + wc * 32 + 8 * fq, bcol0 = u.pn * BM + wc * 32 + 8 * fq;
        f32x4 bv[2][2];
#pragma unroll
        for (int bj = 0; bj < 2; ++bj)
#pragma unroll
            for (int n = 0; n < 2; ++n) bv[bj][n] = bias ? *(const f32x4*)(bias + bcol0 + bj * HALF + 4 * n) : (f32x4){0.f, 0.f, 0.f, 0.f};
#pragma unroll
        for (int ai = 0; ai < 2; ++ai)
#pragma unroll
            for (int m = 0; m < 4; ++m) { bf16_t* rowp = base + (size_t)(row0 + ai * HALF + m * 16) * ldc + col0;
#pragma unroll
                for (int bj = 0; bj < 2; ++bj) { f32x4 v0 = acc[ai][bj][m][0] + bv[bj][0], v1 = acc[ai][bj][m][1] + bv[bj][1];
                    if (ACT == 1) { f32x2 a = gelu_pk((f32x2){v0[0], v0[1]}), b = gelu_pk((f32x2){v0[2], v0[3]}), c = gelu_pk((f32x2){v1[0], v1[1]}), d = gelu_pk((f32x2){v1[2], v1[3]});
                        v0 = (f32x4){a.x, a.y, b.x, b.y}; v1 = (f32x4){c.x, c.y, d.x, d.y}; }
                    v0 = v0 * sc; v1 = v1 * sc; u32x4 w; w.x = cvt_pk_bf16(v0[0], v0[1]); w.y = cvt_pk_bf16(v0[2], v0[3]); w.z = cvt_pk_bf16(v1[0], v1[1]); w.w = cvt_pk_bf16(v1[2], v1[3]);
                    *(u32x4*)(rowp + bj * HALF) = w; } }
    }
};

struct PanelStats {
    unsigned* xbuf;
    unsigned* cnt;
    unsigned* tmo;
    int ntn; float eps;
    unsigned code;
    __device__ __forceinline__ bool run(const f32x4 (&v)[2][2][4][2], const Unit& u, int wr, int wc, int fr, int fq, PG8_LAS unsigned char* lds, int wid, int lane) const {
        typedef float f32x2v __attribute__((ext_vector_type(2)));
        PG8_LAS f32x2v* P = (PG8_LAS f32x2v*)lds;
        PG8_LAS f32x2v* S = (PG8_LAS f32x2v*)(lds + 8192);
        PG8_LAS unsigned* flag = (PG8_LAS unsigned*)(lds + 8192 + 2048);
#pragma unroll
        for (int ai = 0; ai < 2; ++ai)
#pragma unroll
            for (int m = 0; m < 4; ++m) {
                float s = 0.f;
#pragma unroll
                for (int bj = 0; bj < 2; ++bj)
#pragma unroll
                    for (int n = 0; n < 2; ++n) { const f32x4 x = v[ai][bj][m][n]; s += (x[0] + x[1]) + (x[2] + x[3]); }
                s += __shfl_xor(s, 16); s += __shfl_xor(s, 32);
                const float mw = s * (1.0f / 64.0f); float q = 0.f;
#pragma unroll
                for (int bj = 0; bj < 2; ++bj)
#pragma unroll
                    for (int n = 0; n < 2; ++n) { const f32x4 d = v[ai][bj][m][n] - mw; q += (d[0] * d[0] + d[1] * d[1]) + (d[2] * d[2] + d[3] * d[3]); }
                q += __shfl_xor(q, 16); q += __shfl_xor(q, 32);
                if (fq == 0) P[(ai * HALF + wr * 64 + m * 16 + fr) * 4 + wc] = (f32x2v){mw, q};
            }
        asm volatile("s_waitcnt lgkmcnt(0)" ::: "memory"); __builtin_amdgcn_s_barrier(); asm volatile("" ::: "memory");
#if defined(BROKEN_EXCHANGE_NO_WAIT)
#warning BROKEN CONTROL BUILD: the row-statistics exchange does not wait; results are wrong by design
        if (blockIdx.x >= 64) { const long long t0_ = clock64(); while (clock64() - t0_ < 60000) __builtin_amdgcn_s_sleep(8); }
#endif
        const int row = wid * 32 + (lane & 31);
        if (lane < 32) {
            const f32x2v a = P[row * 4 + 0], b = P[row * 4 + 1], c = P[row * 4 + 2], d = P[row * 4 + 3];
            const float mt = (a.x + b.x + c.x + d.x) * 0.25f;
            const float da = a.x - mt, db = b.x - mt, dc = c.x - mt, dd = d.x - mt;
            const float m2 = (a.y + b.y) + (c.y + d.y) + 64.0f * ((da * da + db * db) + (dc * dc + dd * dd));
            unsigned long long* slot = (unsigned long long*)xbuf + ((size_t)(u.pm * BM + row) * 4 + u.pn);
            __hip_atomic_store(slot, ((unsigned long long)__float_as_uint(m2) << 32) | __float_as_uint(mt), __ATOMIC_RELAXED, __HIP_MEMORY_SCOPE_AGENT);
        }
        asm volatile("s_waitcnt vmcnt(0)" ::: "memory");
        if (lane == 0) __hip_atomic_fetch_add(cnt + 64 * u.pm, 1u, __ATOMIC_RELAXED, __HIP_MEMORY_SCOPE_AGENT);
        if (wid == 0) {
            bool dead = false; const unsigned long long t0 = __builtin_amdgcn_s_memrealtime(); const unsigned want = 8u * (unsigned)ntn;
            for (;;) {
#if defined(BROKEN_EXCHANGE_NO_WAIT)
                break;
#endif
                if ((unsigned)__builtin_amdgcn_readfirstlane(__hip_atomic_load(cnt + 64 * u.pm, __ATOMIC_RELAXED, __HIP_MEMORY_SCOPE_AGENT)) >= want) break;
                if (__builtin_amdgcn_s_memrealtime() - t0 > 2000000ull) {
                    if (lane == 0) { unsigned expect = 0u; __hip_atomic_compare_exchange_strong(tmo + 1, &expect, code | (unsigned)(u.pm & 0xff), __ATOMIC_RELAXED, __ATOMIC_RELAXED, __HIP_MEMORY_SCOPE_AGENT);
                                     __hip_atomic_store(tmo, 1u, __ATOMIC_RELAXED, __HIP_MEMORY_SCOPE_AGENT); }
                    dead = true; break; }
                __builtin_amdgcn_s_sleep(2);
            }
            __builtin_amdgcn_fence(__ATOMIC_ACQUIRE, "agent");
            if (lane == 0) flag[0] = dead ? 1u : 0u;
        }
        asm volatile("s_waitcnt vmcnt(0) lgkmcnt(0)" ::: "memory"); __builtin_amdgcn_s_barrier(); asm volatile("" ::: "memory");
        const bool bad = flag[0] != 0u;
        if (lane < 32) {
            const unsigned long long* slot = (const unsigned long long*)xbuf + (size_t)(u.pm * BM + row) * 4; float mt[4], m2[4]; float ms = 0.f;
#pragma unroll
            for (int t = 0; t < 4; ++t) { if (t < ntn) { const unsigned long long w = __hip_atomic_load(slot + t, __ATOMIC_RELAXED, __HIP_MEMORY_SCOPE_AGENT); mt[t] = __uint_as_float((unsigned)w); m2[t] = __uint_as_float((unsigned)(w >> 32)); } else { mt[t] = 0.f; m2[t] = 0.f; } ms += mt[t]; }
            const float mean = ms / (float)ntn; float q = 0.f;
#pragma unroll
            for (int t = 0; t < 4; ++t) if (t < ntn) { const float dm = mt[t] - mean; q += m2[t] + 256.0f * dm * dm; }
            S[row] = (f32x2v){mean, 1.0f / sqrtf(q / (256.0f * (float)ntn) + eps)};
        }
        asm volatile("s_waitcnt lgkmcnt(0)" ::: "memory"); __builtin_amdgcn_s_barrier(); asm volatile("" ::: "memory");
        return bad;
    }
};
struct EpiLnRes {
    static constexpr bool PERM = false, AFTER_DRAIN = true;
    const float* base; float* out; int ldc; const float* bias; PanelStats st; unsigned poison;
    __device__ __forceinline__ void fused(f32x4 (&acc)[2][2][4][2], const Unit& u, int wr, int wc, int fr, int fq, PG8_LAS unsigned char* lds, int wid, int lane) const {
        typedef float f32x2v __attribute__((ext_vector_type(2)));
        const PG8_LAS f32x2v* S = (const PG8_LAS f32x2v*)(lds + 8192);
        const int col0 = u.pn * BM + wc * 32 + 4 * fq;
#pragma unroll
        for (int bj = 0; bj < 2; ++bj)
#pragma unroll
            for (int n = 0; n < 2; ++n) { const f32x4 bv = bias ? *(const f32x4*)(bias + col0 + bj * HALF + n * 16) : (f32x4){0.f, 0.f, 0.f, 0.f};
#pragma unroll
                for (int ai = 0; ai < 2; ++ai)
#pragma unroll
                    for (int m = 0; m < 4; ++m) acc[ai][bj][m][n] += bv; }
        f32x4 pre[4][2][2];
#pragma unroll
        for (int m = 0; m < 4; ++m) { const size_t off = (size_t)(u.pm * BM + wr * 64 + m * 16 + fr) * ldc + col0;
#pragma unroll
            for (int bj = 0; bj < 2; ++bj)
#pragma unroll
                for (int n = 0; n < 2; ++n) pre[m][bj][n] = *(const f32x4*)(base + off + bj * HALF + n * 16); }
        const bool bad = st.run(acc, u, wr, wc, fr, fq, lds, wid, lane) || poison != 0u;
        const float qnan = __builtin_nanf("");
#pragma unroll
        for (int ai = 0; ai < 2; ++ai)
#pragma unroll
            for (int m = 0; m < 4; ++m) { const int r = ai * HALF + wr * 64 + m * 16 + fr; const f32x2v sr = S[r]; const size_t off = (size_t)(u.pm * BM + r) * ldc + col0;
#pragma unroll
                for (int bj = 0; bj < 2; ++bj)
#pragma unroll
                    for (int n = 0; n < 2; ++n) { const f32x4 bs = ai == 0 ? pre[m][bj][n] : *(const f32x4*)(base + off + bj * HALF + n * 16); f32x4 o = bs + (acc[ai][bj][m][n] - sr.x) * sr.y;
                        if (bad) o = (f32x4){qnan, qnan, qnan, qnan}; *(f32x4*)(out + off + bj * HALF + n * 16) = o; }
                if (m & 1) asm volatile("" ::: "memory"); }
    }
};
struct EpiLnResLn {
    static constexpr bool PERM = false, AFTER_DRAIN = true;
    const float* base; float* out; bf16_t* xn; int ldc; const float* bias; PanelStats st1, st2; unsigned poison;
    __device__ __forceinline__ void fused(f32x4 (&acc)[2][2][4][2], const Unit& u, int wr, int wc, int fr, int fq, PG8_LAS unsigned char* lds, int wid, int lane) const {
        typedef float f32x2v __attribute__((ext_vector_type(2))); typedef unsigned u32x2v __attribute__((ext_vector_type(2)));
        const PG8_LAS f32x2v* S = (const PG8_LAS f32x2v*)(lds + 8192);
        const int col0 = u.pn * BM + wc * 32 + 4 * fq;
#pragma unroll
        for (int bj = 0; bj < 2; ++bj)
#pragma unroll
            for (int n = 0; n < 2; ++n) { const f32x4 bv = bias ? *(const f32x4*)(bias + col0 + bj * HALF + n * 16) : (f32x4){0.f, 0.f, 0.f, 0.f};
#pragma unroll
                for (int ai = 0; ai < 2; ++ai)
#pragma unroll
                    for (int m = 0; m < 4; ++m) acc[ai][bj][m][n] += bv; }
        bool bad = st1.run(acc, u, wr, wc, fr, fq, lds, wid, lane) || poison != 0u;
        const float qnan = __builtin_nanf("");
#pragma unroll
        for (int ai = 0; ai < 2; ++ai)
#pragma unroll
            for (int m = 0; m < 4; ++m) { const int r = ai * HALF + wr * 64 + m * 16 + fr; const f32x2v sr = S[r]; const size_t off = (size_t)(u.pm * BM + r) * ldc + col0;
#pragma unroll
                for (int bj = 0; bj < 2; ++bj)
#pragma unroll
                    for (int n = 0; n < 2; ++n) { const f32x4 bs = *(const f32x4*)(base + off + bj * HALF + n * 16); acc[ai][bj][m][n] = bs + (acc[ai][bj][m][n] - sr.x) * sr.y; }
                asm volatile("" : "+v"(acc[ai][0][m][0]), "+v"(acc[ai][0][m][1]), "+v"(acc[ai][1][m][0]), "+v"(acc[ai][1][m][1]));
                if (m & 1) asm volatile("" ::: "memory"); }
        const bool bad1 = bad;
        bad = st2.run(acc, u, wr, wc, fr, fq, lds, wid, lane) || bad;
#pragma unroll
        for (int ai = 0; ai < 2; ++ai)
#pragma unroll
            for (int m = 0; m < 4; ++m) { const int r = ai * HALF + wr * 64 + m * 16 + fr; const f32x2v sr = S[r]; const size_t off = (size_t)(u.pm * BM + r) * ldc + col0;
#pragma unroll
                for (int bj = 0; bj < 2; ++bj)
#pragma unroll
                    for (int n = 0; n < 2; ++n) { const f32x4 x1 = acc[ai][bj][m][n]; *(f32x4*)(out + off + bj * HALF + n * 16) = bad1 ? (f32x4){qnan, qnan, qnan, qnan} : x1;
                        const f32x4 o = (x1 - sr.x) * sr.y; u32x2v w; w.x = cvt_pk_bf16(o[0], o[1]); w.y = cvt_pk_bf16(o[2], o[3]);
                        if (bad) { w.x = 0x7fc07fc0u; w.y = 0x7fc07fc0u; } *(u32x2v*)(xn + off + bj * HALF + n * 16) = w; }
                asm volatile("" ::: "memory"); }
    }
};

template <class Epi, class Sched, bool ALIGN_EPI = false, bool SP2 = false>
__device__ __forceinline__ void gemm_phase(PG8_LAS unsigned char* lds, const Gemm g, const Sched& S, const Epi& E) {
    const int tid = threadIdx.x, wid = __builtin_amdgcn_readfirstlane(tid >> 6), lane = tid & 63, wr = wid >> 2, wc = wid & 3, fr = lane & 15, fq = lane >> 4;
    const int K = g.K, nt = K / BK;
    unsigned voffA[2], voffB[2];
#pragma unroll
    for (int i = 0; i < 2; ++i) { int R, C; stage_rc(tid * 16 + i * 8192, R, C); const int Rb = Epi::PERM ? ((R & ~31) + perm32(R & 31)) : R;
        voffA[i] = (unsigned)(R * K + C) * 2u; voffB[i] = (unsigned)(Rb * K + C) * 2u; }
    const size_t kstep = (size_t)(BK * 2);
    const size_t hstep = (size_t)HALF * K * 2;
    const size_t tstep = 2 * hstep;
    const unsigned ldsw = (unsigned)wid * 1024u;
    const int aoff = lds_byte(wr * 64 + fr, fq * 8), boff = lds_byte(wc * 32 + fr, fq * 8);
#define PG8_SA(b, h) (((b) * 2 + (h)) * HTB)
#define PG8_SB(b, h) ((4 + (b) * 2 + (h)) * HTB)
#define PG8_STAGE(bufoff, gbase, voff) do { _Pragma("unroll") for (int _i = 0; _i < 2; ++_i) \
        __builtin_amdgcn_global_load_lds((const unsigned*)((const char*)(gbase) + (voff)[_i]), (PG8_LAS unsigned*)(lds + (bufoff) + ldsw + _i * 8192), 16, 0, 0); } while (0)
#define PG8_LDA(dst, b, h) do { _Pragma("unroll") for (int m = 0; m < 4; ++m) _Pragma("unroll") for (int k = 0; k < 2; ++k) dst[m][k] = *(const PG8_LAS bf16x8*)(lds + PG8_SA(b, h) + aoff + m * 2048 + k * 1024); } while (0)
#define PG8_LDB(dst, b, h) do { _Pragma("unroll") for (int n = 0; n < 2; ++n) _Pragma("unroll") for (int k = 0; k < 2; ++k) dst[n][k] = *(const PG8_LAS bf16x8*)(lds + PG8_SB(b, h) + boff + n * 2048 + k * 1024); } while (0)
#define PG8_MMA(ai, bj, At, Bt) do { __builtin_amdgcn_s_setprio(1); _Pragma("unroll") for (int m = 0; m < 4; ++m) _Pragma("unroll") for (int n = 0; n < 2; ++n) _Pragma("unroll") for (int k = 0; k < 2; ++k) \
        acc[ai][bj][m][n] = __builtin_amdgcn_mfma_f32_16x16x32_bf16(Bt[n][k], At[m][k], acc[ai][bj][m][n], 0, 0, 0); __builtin_amdgcn_s_setprio(0); } while (0)
#define PG8_WAIT_V(n) asm volatile("s_waitcnt vmcnt(" #n ")" ::: "memory")
#define PG8_WAIT_L(n) asm volatile("s_waitcnt lgkmcnt(" #n ")" ::: "memory")
#define PG8_BAR __builtin_amdgcn_s_barrier()
#define PG8_SCHED __builtin_amdgcn_sched_barrier(0)
    Unit cur, nxt; int ui = 0;
    if (!S.next(0, cur)) return;
    f32x4 acc[2][2][4][2];
#pragma unroll
    for (int a = 0; a < 2; ++a)
#pragma unroll
        for (int b = 0; b < 2; ++b)
#pragma unroll
            for (int m = 0; m < 4; ++m)
#pragma unroll
                for (int n = 0; n < 2; ++n) acc[a][b][m][n] = (f32x4){0.f, 0.f, 0.f, 0.f};
    bf16x8 At[4][2], B0[2][2], B1[2][2];
    const char* cA = (const char*)g.A + (size_t)cur.pm * tstep; const char* cB = (const char*)g.Bt + (size_t)cur.pn * tstep;
    S.a_ready(cur);
    if constexpr (SP2) {
        PG8_STAGE(PG8_SB(0, 0), cB, voffB); PG8_STAGE(PG8_SB(0, 1), cB + hstep, voffB); PG8_STAGE(PG8_SA(0, 0), cA, voffA); PG8_STAGE(PG8_SA(0, 1), cA + hstep, voffA);
        if (wr == 1) PG8_BAR;
        PG8_WAIT_V(2); PG8_BAR;
        PG8_STAGE(PG8_SB(1, 0), cB + kstep, voffB); PG8_STAGE(PG8_SA(1, 0), cA + kstep, voffA); PG8_STAGE(PG8_SB(1, 1), cB + hstep + kstep, voffB);
        PG8_WAIT_V(6); PG8_BAR;
    } else {
        PG8_STAGE(PG8_SB(0, 0), cB, voffB); PG8_STAGE(PG8_SA(0, 0), cA, voffA); PG8_STAGE(PG8_SB(0, 1), cB + hstep, voffB); PG8_STAGE(PG8_SA(0, 1), cA + hstep, voffA);
        if (wr == 1) PG8_BAR;
        PG8_WAIT_V(4); PG8_BAR;
        PG8_STAGE(PG8_SB(1, 0), cB + kstep, voffB); PG8_STAGE(PG8_SA(1, 0), cA + kstep, voffA); PG8_STAGE(PG8_SB(1, 1), cB + hstep + kstep, voffB);
        PG8_WAIT_V(6); PG8_BAR;
    }
    for (;;) {
        const bool has_next = S.next(ui + 1, nxt);
        const char* nA = has_next ? (const char*)g.A + (size_t)nxt.pm * tstep : cA; const char* nB = has_next ? (const char*)g.Bt + (size_t)nxt.pn * tstep : cB;
        for (int t = 0; t < nt; t += 2) {
            const bool last = (t == nt - 2);
            const char* a1 = cA + (size_t)(t + 1) * kstep;
            const char* a2 = last ? nA : cA + (size_t)(t + 2) * kstep; const char* b2 = last ? nB : cB + (size_t)(t + 2) * kstep;
            const char* a3 = a2 + kstep; const char* b3 = b2 + kstep;
            if (last && has_next) S.a_ready(nxt);
            if constexpr (SP2) {
            PG8_LDB(B0, 0, 0); PG8_LDB(B1, 0, 1); PG8_SCHED; PG8_LDA(At, 0, 0); PG8_STAGE(PG8_SA(1, 1), a1 + hstep, voffA);
            PG8_WAIT_V(8); PG8_WAIT_L(0); PG8_BAR; PG8_MMA(0, 0, At, B0); PG8_MMA(0, 1, At, B1); PG8_BAR; PG8_SCHED;
            PG8_LDA(At, 0, 1); PG8_STAGE(PG8_SB(0, 0), b2, voffB); PG8_STAGE(PG8_SB(0, 1), b2 + hstep, voffB); PG8_STAGE(PG8_SA(0, 0), a2, voffA);
            PG8_WAIT_V(8); PG8_WAIT_L(0); PG8_BAR; PG8_MMA(1, 0, At, B0); PG8_MMA(1, 1, At, B1); PG8_BAR; PG8_SCHED;
            PG8_LDB(B0, 1, 0); PG8_LDB(B1, 1, 1); PG8_SCHED; PG8_LDA(At, 1, 0); PG8_STAGE(PG8_SA(0, 1), a2 + hstep, voffA);
            PG8_WAIT_V(8); PG8_WAIT_L(0); PG8_BAR; PG8_MMA(0, 0, At, B0); PG8_MMA(0, 1, At, B1); PG8_BAR; PG8_SCHED;
            PG8_LDA(At, 1, 1); PG8_STAGE(PG8_SB(1, 0), b3, voffB); PG8_STAGE(PG8_SB(1, 1), b3 + hstep, voffB); PG8_STAGE(PG8_SA(1, 0), a3, voffA);
            PG8_WAIT_V(8); PG8_WAIT_L(0); PG8_BAR; PG8_MMA(1, 0, At, B0); PG8_MMA(1, 1, At, B1); PG8_BAR; PG8_SCHED;
            } else {
            PG8_LDB(B0, 0, 0); PG8_SCHED; PG8_LDA(At, 0, 0); PG8_STAGE(PG8_SA(1, 1), a1 + hstep, voffA);
            PG8_WAIT_L(8); PG8_BAR; PG8_WAIT_L(0); PG8_MMA(0, 0, At, B0); PG8_BAR; PG8_SCHED;
            PG8_LDB(B1, 0, 1); PG8_STAGE(PG8_SB(0, 0), b2, voffB);
            PG8_BAR; PG8_WAIT_L(0); PG8_MMA(0, 1, At, B1); PG8_BAR;
            PG8_LDA(At, 0, 1); PG8_STAGE(PG8_SA(0, 0), a2, voffA);
            PG8_BAR; PG8_WAIT_L(0); PG8_MMA(1, 0, At, B0); PG8_BAR; PG8_SCHED;
            PG8_STAGE(PG8_SB(0, 1), b2 + hstep, voffB);
            PG8_WAIT_V(6); PG8_BAR; PG8_MMA(1, 1, At, B1); PG8_BAR;
            PG8_LDB(B0, 1, 0); PG8_SCHED; PG8_LDA(At, 1, 0); PG8_STAGE(PG8_SA(0, 1), a2 + hstep, voffA);
            PG8_WAIT_L(8); PG8_BAR; PG8_WAIT_L(0); PG8_MMA(0, 0, At, B0); PG8_BAR; PG8_SCHED;
            PG8_LDB(B1, 1, 1); PG8_STAGE(PG8_SB(1, 0), b3, voffB);
            PG8_BAR; PG8_WAIT_L(0); PG8_MMA(0, 1, At, B1); PG8_BAR;
            PG8_LDA(At, 1, 1); PG8_STAGE(PG8_SA(1, 0), a3, voffA);
            PG8_BAR; PG8_WAIT_L(0); PG8_MMA(1, 0, At, B0); PG8_BAR; PG8_SCHED;
            PG8_STAGE(PG8_SB(1, 1), b3 + hstep, voffB);
            PG8_WAIT_V(6); PG8_BAR; PG8_MMA(1, 1, At, B1); PG8_BAR;
            }
        }
        if constexpr (ALIGN_EPI) { if (wr == 0) PG8_BAR; }
        if constexpr (!Epi::AFTER_DRAIN) { E(acc, cur, wr, wc, fr, fq); S.done(cur); }
        if (!has_next) break;
#pragma unroll
        for (int a = 0; a < 2; ++a)
#pragma unroll
            for (int b = 0; b < 2; ++b)
#pragma unroll
                for (int m = 0; m < 4; ++m)
#pragma unroll
                    for (int n = 0; n < 2; ++n) acc[a][b][m][n] = (f32x4){0.f, 0.f, 0.f, 0.f};
        cur = nxt; cA = nA; cB = nB; ++ui;
        if constexpr (ALIGN_EPI) { if (wr == 1) PG8_BAR; }
    }
    PG8_WAIT_V(0);
    if constexpr (!ALIGN_EPI) { if (wr == 0) PG8_BAR; }
    PG8_BAR;
    if constexpr (Epi::AFTER_DRAIN) { E.fused(acc, cur, wr, wc, fr, fq, lds, wid, lane); S.done(cur); }
#undef PG8_SA
#undef PG8_SB
#undef PG8_STAGE
#undef PG8_LDA
#undef PG8_LDB
#undef PG8_MMA
#undef PG8_WAIT_V
#undef PG8_WAIT_L
#undef PG8_BAR
#undef PG8_SCHED
}
}
#define GAS __attribute__((address_space(1)))
#define LAS __attribute__((address_space(3)))
typedef unsigned short bf16;
typedef unsigned v4u __attribute__((ext_vector_type(4)));
typedef float f32x4 __attribute__((ext_vector_type(4)));
typedef short bf16x8 __attribute__((ext_vector_type(8)));
typedef GAS unsigned gu32;
typedef GAS unsigned long long gu64;
#define RLX_AGENT __ATOMIC_RELAXED, __HIP_MEMORY_SCOPE_AGENT
#define LDS_WAIT() asm volatile("s_waitcnt lgkmcnt(0)" ::: "memory")
#define VM_WAIT() asm volatile("s_waitcnt vmcnt(0)" ::: "memory")
__device__ __forceinline__ unsigned long long rt() { return __builtin_amdgcn_s_memrealtime(); }
__device__ __forceinline__ unsigned f2bf(float f) { unsigned u = __builtin_bit_cast(unsigned, f); return (u + 0x7fffu + ((u >> 16) & 1u)) >> 16; }
__device__ __forceinline__ unsigned pk2(float lo, float hi) { return f2bf(lo) | (f2bf(hi) << 16); }

#define XB_TMO      128
#define XB_XCNT(j)  (256  + 64 * (j))
#define XB_XSUB(j)  (1280 + 64 * (j))
#define XB_XGEN(j)  (2304 + 64 * (j))
#define XB_TOP      3328
#define XB_TOPGEN   3392
#define XCD_BAR_WORDS 3456
#define XB_SPIN_CAP (1u << 18)

__device__ __forceinline__ unsigned xb_ld(unsigned* p)              { return __hip_atomic_load(p, __ATOMIC_RELAXED, __HIP_MEMORY_SCOPE_AGENT); }
__device__ __forceinline__ unsigned xb_add(unsigned* p, unsigned v) { return __hip_atomic_fetch_add(p, v, __ATOMIC_RELAXED, __HIP_MEMORY_SCOPE_AGENT); }
__device__ __forceinline__ unsigned xb_xcc_id() { return (unsigned)__builtin_amdgcn_s_getreg((3 << 11) | 20) & 0xFu; }
#define XB_SPIN(cond, bar) do { unsigned _sp = 0; while (cond) { __builtin_amdgcn_s_sleep(1); \
    if ((++_sp & 255u) == 0u) { if (xb_ld(&(bar)[XB_TMO])) break; if (_sp > XB_SPIN_CAP) { atomicAdd(&(bar)[XB_TMO], 1u); break; } } } } while (0)

struct XcdBarrier {
    unsigned* bar; unsigned x;
    volatile LAS unsigned* st;
};

__device__ __forceinline__ XcdBarrier xcd_barrier_post(unsigned* bar, volatile LAS unsigned* st) {
    XcdBarrier b; b.bar = bar; b.x = xb_xcc_id(); b.st = st;
    if (threadIdx.x == 0) (void)xb_add(&bar[XB_XCNT(b.x)], 1u);
    return b;
}
__device__ __forceinline__ void xcd_barrier_complete(unsigned* bar, unsigned x, unsigned& nloc, unsigned& nx) {
    const unsigned G = gridDim.x * gridDim.y * gridDim.z;
    unsigned sum, cnt, mine, sp = 0u;
    for (;;) {
        sum = 0u; cnt = 0u; mine = 0u;
#pragma unroll
        for (unsigned j = 0; j < 16; ++j) { const unsigned c = xb_ld(&bar[XB_XCNT(j)]); sum += c; cnt += (c > 0u) ? 1u : 0u; mine = (j == x) ? c : mine; }
        if (sum == G) break;
        __builtin_amdgcn_s_sleep(1);
        if ((++sp & 255u) == 0u) { if (xb_ld(&bar[XB_TMO])) break; if (sp > XB_SPIN_CAP) { atomicAdd(&bar[XB_TMO], 1u); break; } }
    }
    nloc = mine > 0u ? mine : 1u; nx = cnt > 0u ? cnt : 1u;
}

__device__ __forceinline__ void xcd_barrier(const XcdBarrier& b) {
    asm volatile("s_waitcnt vmcnt(0)" ::: "memory");
    __syncthreads();
    if (threadIdx.x == 0) {
        unsigned* bar = b.bar;
        __builtin_amdgcn_s_waitcnt(0);
        unsigned nloc = b.st[0], nx = b.st[1];
        if (nloc == 0u) { xcd_barrier_complete(bar, b.x, nloc, nx); b.st[0] = nloc; b.st[1] = nx; }
        const unsigned old = xb_add(&bar[XB_XSUB(b.x)], 1u);
        const unsigned gen = old / nloc;
        if (old + 1u == (gen + 1u) * nloc) {
            __builtin_amdgcn_fence(__ATOMIC_RELEASE, "agent");
            asm volatile("s_waitcnt vmcnt(0)" ::: "memory");
            const unsigned og = xb_add(&bar[XB_TOP], 1u);
            const unsigned tg = og / nx;
            if (og + 1u == (tg + 1u) * nx) xb_add(&bar[XB_TOPGEN], 1u);
            else XB_SPIN(xb_ld(&bar[XB_TOPGEN]) == tg, bar);
            __builtin_amdgcn_fence(__ATOMIC_ACQUIRE, "agent");
            xb_add(&bar[XB_XGEN(b.x)], 1u);
            asm volatile("s_waitcnt vmcnt(0)" ::: "memory");
        } else {
            XB_SPIN(xb_ld(&bar[XB_XGEN(b.x)]) == gen, bar);
            __builtin_amdgcn_fence(__ATOMIC_ACQUIRE, "agent");
            asm volatile("s_waitcnt vmcnt(0)" ::: "memory");
        }
    }
    __syncthreads();
}

#ifndef NAIVE_HGRN
#define NAIVE_HGRN 0
#endif
constexpr int NWAVES = 8;
constexpr int DM = 2048, NPROJ = 7168, SEQ = 2048, NBATCH = 4, MP = NBATCH * SEQ  , MS = 32, MTOK = MP + MS  , MPAD = 8448, MMEM = 1024;
constexpr int WA = 768, WM = 512, NMEM = 256, PASTW = 2048;
constexpr float QSCALE = 0.12751743082459868f;
constexpr float DN_ALPHA = 1.189207115002721f;
constexpr float LN_EPS = 1e-5f, RMS_EPS = 1e-6f;
constexpr size_t OUT_Y = 0, OUT_YS = 16777216, OUT_KP = 16842752, OUT_VP = 23134208, OUT_SP = 29425664, OUT_MKP = 29818880, OUT_MVP = 30343168,
                 OUT_KS = 30867456, OUT_VS = 30892032, OUT_SS = 30916608, OUT_TOTAL = 34062336;
constexpr size_t MiB = 1u << 20;
constexpr size_t WS_CTL = 0, CTL_ZERO_BYTES = 1 * MiB;
constexpr size_t WS_LB = 1 * MiB;
constexpr size_t WS_COS = 2 * MiB, WS_SIN = 3 * MiB;
constexpr size_t WS_XB = 4 * MiB;
constexpr size_t WS_WT = 42 * MiB;
constexpr size_t WS_WOUTT = 74 * MiB;
constexpr size_t WS_QA = 82 * MiB, WS_KA = 95 * MiB, WS_VA = 108 * MiB, WS_GA = 121 * MiB;
constexpr size_t WS_QB = 134 * MiB, WS_KB = 147 * MiB, WS_VB = 160 * MiB, WS_GB = 173 * MiB;
constexpr size_t WS_LF = 186 * MiB;
constexpr size_t WS_QM = 211 * MiB, WS_GM = 220 * MiB;
constexpr size_t WS_MK = 229 * MiB, WS_MV = 230 * MiB;
constexpr size_t WS_Z = 231 * MiB;
constexpr size_t WS_OP = 264 * MiB;
constexpr size_t WS_LSE = 300 * MiB;
constexpr size_t WS_U = 301 * MiB, WS_SPV = 325 * MiB;
constexpr size_t WS_DC = 349 * MiB;
constexpr size_t WS_RS = 350 * MiB;
constexpr size_t WS_SAMP = 351 * MiB;
constexpr size_t WS_HO = 353 * MiB;
constexpr size_t WS_END = 384 * MiB;
constexpr int CW_BAR = 4096;
constexpr int RING_OFF = 0, RING_BYTES = 131072;
constexpr int LDSCTL_OFF = RING_BYTES, MISC_OFF = LDSCTL_OFF + 320;
constexpr int LDS_BYTES = 147456;

struct Args { const float* in[15]; float* out; unsigned char* ws; };

__device__ __forceinline__ float bf2f(unsigned h) { return __uint_as_float(h << 16); }
__device__ __forceinline__ float bflo(unsigned w) { return __uint_as_float(w << 16); }
__device__ __forceinline__ float bfhi(unsigned w) { return __uint_as_float(w & 0xffff0000u); }
__device__ __forceinline__ float wave_sum(float v) {
#pragma unroll
    for (int o = 1; o < 64; o <<= 1) v += __shfl_xor(v, o);
    return v;
}
__device__ __forceinline__ float sigmoidf_(float x) { return __builtin_amdgcn_rcpf(1.0f + __builtin_amdgcn_exp2f(-1.4426950408889634f * x)); }
__device__ __forceinline__ float siluf_(float x) { return x * sigmoidf_(x); }

namespace pg8 {
__host__ __device__ __forceinline__ int rowmap_win(int n) { if (n < 1536) { const int d = n & 127; return (n & ~127) + 8 * ((d & 63) >> 2) + 4 * (d >> 6) + (d & 3); } return n; }

struct EpiProj {
    static constexpr bool PERM = true, AFTER_DRAIN = false;
    unsigned char* ws; float* out;
    __device__ __forceinline__ void operator()(const f32x4 (&acc)[2][2][4][2], const Unit& u, int wr, int wc, int fr, int fq) const {
        const int pn = u.pn, pm = u.pm;
        int seg, colt;
        if (pn < 24) { seg = pn / 3; colt = (pn % 3) * 256; } else if (pn < 28) { seg = 8 + ((pn - 24) >> 1); colt = ((pn - 24) & 1) * 256; } else { seg = 10 + ((pn - 28) >> 1); colt = ((pn - 28) & 1) * 256; }
        const float* cosT = (const float*)(ws + WS_COS); const float* sinT = (const float*)(ws + WS_SIN); const float* LB = (const float*)(ws + WS_LB);
#pragma unroll
        for (int ai = 0; ai < 2; ++ai)
#pragma unroll
            for (int m = 0; m < 4; ++m) {
                const int row = pm * BM + ai * HALF + wr * 64 + m * 16 + fr;
#pragma unroll
                for (int bj = 0; bj < 2; ++bj) {
                    const int c0 = colt + bj * HALF + wc * 32 + 8 * fq;
                    f32x4 v0 = acc[ai][bj][m][0], v1 = acc[ai][bj][m][1];
                    if (seg >= 10) {
                        const int mr = row - MPAD;
                        float* o = out + (seg == 10 ? OUT_MKP : OUT_MVP) + (size_t)mr * WM + c0;
                        *(f32x4*)o = v0; *(f32x4*)(o + 4) = v1;
                        bf16_t* b = (bf16_t*)(ws + (seg == 10 ? WS_MK : WS_MV)) + (size_t)mr * WM + c0;
                        u32x4 w; w.x = cvt_pk_bf16(v0[0], v0[1]); w.y = cvt_pk_bf16(v0[2], v0[3]); w.z = cvt_pk_bf16(v1[0], v1[1]); w.w = cvt_pk_bf16(v1[2], v1[3]);
                        *(u32x4*)b = w;
                        continue;
                    }
                    if (seg <= 1) {
                        const int i0 = 4 * ((c0 & 127) >> 3);
                        const int pr = row < MP ? (row & (SEQ - 1)) : SEQ;
                        const f32x4 cs = *(const f32x4*)(cosT + pr * 64 + i0), sn = *(const f32x4*)(sinT + pr * 64 + i0);
                        const f32x4 o1 = v0 * cs - v1 * sn, o2 = v1 * cs + v0 * sn;
                        if (seg == 1) {
                            if (row < MTOK) {
                                float* o = (row < MP ? out + OUT_KP + (size_t)row * WA : out + OUT_KS + (size_t)(row - MP) * WA) + (c0 & ~127) + i0;
                                *(f32x4*)o = o1; *(f32x4*)(o + 64) = o2;
                            }
                            v0 = o1; v1 = o2;
                        } else { v0 = o1 * QSCALE; v1 = o2 * QSCALE; }
                    } else if (seg == 2) {
                        if (row < MTOK) {
                            float* o = (row < MP ? out + OUT_VP + (size_t)row * WA : out + OUT_VS + (size_t)(row - MP) * WA) + c0;
                            *(f32x4*)o = v0; *(f32x4*)(o + 4) = v1;
                        }
                    } else if (seg == 3 || seg == 7 || seg == 9) {
#pragma unroll
                        for (int e = 0; e < 4; ++e) { v0[e] = siluf_(v0[e]); v1[e] = siluf_(v1[e]); }
                    } else if (seg == 5) {
                        const f32x4 la = *(const f32x4*)(LB + c0), lb = *(const f32x4*)(LB + c0 + 4);
                        f32x4 l0, l1;
#pragma unroll
                        for (int e = 0; e < 4; ++e) {
                            const float sa = sigmoidf_(v0[e]), sb = sigmoidf_(v1[e]);
                            const float fa = la[e] + (1.0f - la[e]) * sa, fb = lb[e] + (1.0f - lb[e]) * sb;
                            l0[e] = __logf(fa); l1[e] = __logf(fb);
                            v0[e] = (1.0f - la[e]) * (1.0f - sa); v1[e] = (1.0f - lb[e]) * (1.0f - sb);
                        }
                        float* lf = (float*)(ws + WS_LF) + (size_t)row * WA + c0;
                        *(f32x4*)lf = l0; *(f32x4*)(lf + 4) = l1;
                    } else if (seg == 8) { v0 = v0 * QSCALE; v1 = v1 * QSCALE; }
                    size_t boff; int ld;
                    if (seg < 8) { boff = WS_QA + (size_t)seg * 13 * MiB; ld = WA; } else { boff = (seg == 8 ? WS_QM : WS_GM); ld = WM; }
                    bf16_t* b = (bf16_t*)(ws + boff) + (size_t)row * ld + c0;
                    u32x4 w; w.x = cvt_pk_bf16(v0[0], v0[1]); w.y = cvt_pk_bf16(v0[2], v0[3]); w.z = cvt_pk_bf16(v1[0], v1[1]); w.w = cvt_pk_bf16(v1[2], v1[3]);
                    *(u32x4*)b = w;
                }
            }
    }
};
static_assert(WS_KA == WS_QA + 13 * MiB && WS_VA == WS_QA + 26 * MiB && WS_GA == WS_QA + 39 * MiB && WS_QB == WS_QA + 52 * MiB && WS_KB == WS_QA + 65 * MiB && WS_VB == WS_QA + 78 * MiB && WS_GB == WS_QA + 91 * MiB, "segment buffers 13 MiB apart");

struct SchedProj {
    int G, c;
    __device__ __forceinline__ bool next(int i, Unit& u) const {
        const int L = i * G + c; constexpr int nM = 33, nN = 28, nwg = nM * nN;
        if (L >= nwg + 16) return false;
        if (L >= nwg) { const int j = L - nwg; u.pm = nM + (j >> 2); u.pn = nN + (j & 3); return true; }
        int wgid = L; { const int q = nwg / NXCD, r = nwg % NXCD, xcd = wgid % NXCD, off = wgid / NXCD; wgid = (xcd < r ? xcd * (q + 1) : r * (q + 1) + (xcd - r) * q) + off; }
        const int nig = WGM * nN, gid = wgid / nig, fm = gid * WGM, gsz = (nM - fm) < WGM ? (nM - fm) : WGM;
        u.pm = fm + ((wgid % nig) % gsz); u.pn = (wgid % nig) / gsz; return true;
    }
    __device__ __forceinline__ void a_ready(const Unit&) const {}
    __device__ __forceinline__ void done(const Unit&) const {}
};

struct EpiRes {
    static constexpr bool PERM = false, AFTER_DRAIN = false;
    const float* x; float* out;
    __device__ __forceinline__ void operator()(const f32x4 (&acc)[2][2][4][2], const Unit& u, int wr, int wc, int fr, int fq) const {
#pragma unroll
        for (int ai = 0; ai < 2; ++ai)
#pragma unroll
            for (int m = 0; m < 4; ++m) {
                const size_t ro = (size_t)(u.pm * BM + ai * HALF + wr * 64 + m * 16 + fr) * DM;
#pragma unroll
                for (int bj = 0; bj < 2; ++bj)
#pragma unroll
                    for (int n = 0; n < 2; ++n) {
                        const int col = u.pn * BM + bj * HALF + wc * 32 + n * 16 + 4 * fq;
                        const f32x4 xv = *(const f32x4*)(x + ro + col);
                        *(f32x4*)(out + ro + col) = acc[ai][bj][m][n] + xv * DN_ALPHA;
                    }
            }
    }
};
}

struct Frame {
    LAS unsigned char* lds;
    int tid, lane, wave, vcu, G, gw, NGW;
    unsigned char* ws; float* out;
    const float* in[15];
};

template <bool PERMROWS>
__device__ __forceinline__ void p0_transpose_item(const float* W, int K, int N, bf16* WT, int row_off, LAS float* scr, int item, int lane) {
    const int nblk = N / 32, kb = item / nblk, nb = item % nblk, k0 = 64 * kb, n0 = 32 * nb;
#pragma unroll 8
    for (int i = 0; i < 32; ++i) { const int kk = 2 * i + (lane >> 5); scr[kk * 33 + (lane & 31)] = W[(size_t)(k0 + kk) * N + n0 + (lane & 31)]; }
    LDS_WAIT(); asm volatile("" ::: "memory");
    const int c = lane & 7;
#pragma unroll
    for (int j = 0; j < 4; ++j) { const int n = (lane >> 3) + 8 * j; const LAS float* s = scr + (8 * c) * 33 + n;
        v4u o; o.x = pk2(s[0 * 33], s[1 * 33]); o.y = pk2(s[2 * 33], s[3 * 33]); o.z = pk2(s[4 * 33], s[5 * 33]); o.w = pk2(s[6 * 33], s[7 * 33]);
        const int drow = row_off + (PERMROWS ? pg8::rowmap_win(n0 + n) : n0 + n);
        *(GAS v4u*)(WT + (size_t)drow * K + k0 + 8 * c) = o; }
    LDS_WAIT(); asm volatile("" ::: "memory");
}
__device__ __forceinline__ void p0_prologue(Frame& F) {
    LAS float* scr = (LAS float*)(F.lds + RING_OFF + F.wave * 16384);
    const float* w_in = F.in[8]; const float* w_mem = F.in[9]; const float* w_out = F.in[12];
    bf16* WT = (bf16*)(F.ws + WS_WT); bf16* WOT = (bf16*)(F.ws + WS_WOUTT); bf16* XB = (bf16*)(F.ws + WS_XB);
    constexpr int I_IN = (DM / 64) * (NPROJ / 32), I_MEM = (DM / 64) * (1024 / 32), I_OUT = (DM / 64) * (DM / 32);
    for (int it = F.gw; it < I_IN + I_MEM + I_OUT; it += F.NGW) {
        int r = it;
        if (r < I_IN) { p0_transpose_item<true>(w_in, DM, NPROJ, WT, 0, scr, r, F.lane); continue; } r -= I_IN;
        if (r < I_MEM) { p0_transpose_item<false>(w_mem, DM, 1024, WT, NPROJ, scr, r, F.lane); continue; } r -= I_MEM;
        p0_transpose_item<false>(w_out, DM, DM, WOT, 0, scr, r, F.lane);
    }
    for (int m = F.gw; m < MPAD + MMEM; m += F.NGW) {
        GAS unsigned long long* o8 = (GAS unsigned long long*)(XB + (size_t)m * DM) + F.lane;
        if (m >= MTOK && m < MPAD) {
#pragma unroll
            for (int j = 0; j < 8; ++j) o8[64 * j] = 0ull;
            continue;
        }
        const float* src = m < MP ? F.in[0] + (size_t)m * DM : (m < MTOK ? F.in[1] + (size_t)(m - MP) * DM : F.in[7] + (size_t)(m - MPAD) * DM);
        const GAS f32x4* xr = (const GAS f32x4*)src + F.lane;
        f32x4 v[8];
#pragma unroll
        for (int j = 0; j < 8; ++j) v[j] = xr[64 * j];
#pragma unroll
        for (int j = 0; j < 8; ++j) o8[64 * j] = (unsigned long long)pk2(v[j].x, v[j].y) | ((unsigned long long)pk2(v[j].z, v[j].w) << 32);
    }
    {
        float* cosT = (float*)(F.ws + WS_COS); float* sinT = (float*)(F.ws + WS_SIN);
        const int gt = F.gw * 64 + F.lane, NT = F.NGW * 64;
        for (int e = gt; e < (SEQ + 1) * 64; e += NT) {
            const int pr = e >> 6, i = e & 63; const double pos = pr < SEQ ? (double)pr : 8192.0;
            double inv = 1.0; for (int k = 0; k < i; ++k) inv *= 0.8659643233600653;
            const double ang = pos * inv; const double kq = __builtin_floor(ang * 0.15915494309189535); const float red = (float)(ang - kq * 6.283185307179586);
            cosT[e] = cosf(red); sinT[e] = sinf(red);
        }
        float* LB = (float*)(F.ws + WS_LB); const float* raw = F.in[10];
        for (int e = gt; e < WA; e += NT) LB[e] = 1.0f / (1.0f + expf(raw[WA + e] - raw[e]));
    }
}

struct SM { float m, l, a0, a1; };
__device__ __forceinline__ void sm_step(SM& s, float sc, float v0, float v1) {
    const float mn = fmaxf(s.m, sc), f = __builtin_amdgcn_exp2f(s.m - mn), p = __builtin_amdgcn_exp2f(sc - mn);
    s.l = s.l * f + p; s.a0 = s.a0 * f + p * v0; s.a1 = s.a1 * f + p * v1; s.m = mn;
}
__device__ __forceinline__ void naive_attn_task(Frame& F, int task) {
    const int lane = F.lane; const bf16* QA = (const bf16*)(F.ws + WS_QA); const bf16* KA = (const bf16*)(F.ws + WS_KA); const bf16* VA = (const bf16*)(F.ws + WS_VA); const bf16* GA = (const bf16*)(F.ws + WS_GA);
    bf16* Z = (bf16*)(F.ws + WS_Z);
    const int r = task / 6, h = task % 6;
    SM s{-1e30f, 0.f, 0.f, 0.f};
    if (r < MP) {
        const int t = r & (SEQ - 1);
        const unsigned qq = *(const unsigned*)(QA + (size_t)r * WA + h * 128 + 2 * lane); const float q0 = bflo(qq), q1 = bfhi(qq);
        for (int br = 0; br < 3; ++br) {
            const int dil = br == 0 ? 1 : (br == 1 ? 4 : 16); int cnt = t / dil; cnt = (cnt < 128 ? cnt : 128) + 1;
            for (int j = 0; j < cnt; ++j) {
                const size_t ko = (size_t)(r - j * dil) * WA + h * 128 + 2 * lane;
                const unsigned kk = *(const unsigned*)(KA + ko), vv = *(const unsigned*)(VA + ko);
                const float sc = wave_sum(q0 * bflo(kk) + q1 * bfhi(kk));
                sm_step(s, sc, bflo(vv), bfhi(vv));
            }
        }
    } else {
        const int bs = r - MP; const int p = 8 * (((2 * lane) & 63) >> 2) + 4 * (lane >> 5) + ((2 * lane) & 3);
        const unsigned qq = *(const unsigned*)(QA + (size_t)r * WA + h * 128 + p); const float q0 = bflo(qq), q1 = bfhi(qq);
        const float* ck = F.in[2]; const float* cv = F.in[3];
        const float2 kn = *(const float2*)(F.out + OUT_KS + (size_t)bs * WA + h * 128 + 2 * lane), vn = *(const float2*)(F.out + OUT_VS + (size_t)bs * WA + h * 128 + 2 * lane);
        const float scn = wave_sum(q0 * kn.x + q1 * kn.y);
        for (int br = 0; br < 3; ++br) {
            const int dil = br == 0 ? 1 : (br == 1 ? 4 : 16);
            sm_step(s, scn, vn.x, vn.y);
            for (int j = 1; j <= 128; ++j) {
                const size_t ko = ((size_t)(bs * PASTW + PASTW - j * dil) * 6 + h) * 128 + 2 * lane;
                const float2 k2 = *(const float2*)(ck + ko), v2 = *(const float2*)(cv + ko);
                const float sc = wave_sum(q0 * k2.x + q1 * k2.y);
                sm_step(s, sc, v2.x, v2.y);
            }
        }
    }
    const float il = 1.0f / s.l; const unsigned gg = *(const unsigned*)(GA + (size_t)r * WA + h * 128 + 2 * lane);
    *(unsigned*)(Z + (size_t)r * DM + h * 128 + 2 * lane) = pk2(s.a0 * il * bflo(gg), s.a1 * il * bfhi(gg));
}
__device__ __forceinline__ void naive_mem_task(Frame& F, int task) {
    const int lane = F.lane; const bf16* QM = (const bf16*)(F.ws + WS_QM); const bf16* GM = (const bf16*)(F.ws + WS_GM); const bf16* MK = (const bf16*)(F.ws + WS_MK); const bf16* MV = (const bf16*)(F.ws + WS_MV);
    bf16* Z = (bf16*)(F.ws + WS_Z);
    const int r = task >> 2, h = task & 3;
    const unsigned qq = *(const unsigned*)(QM + (size_t)r * WM + h * 128 + 2 * lane); const float q0 = bflo(qq), q1 = bfhi(qq);
    SM s{-1e30f, 0.f, 0.f, 0.f};
    if (r < MP) {
        const int b = r >> 11;
        for (int m = 0; m < NMEM; ++m) {
            const size_t ko = (size_t)(b * NMEM + m) * WM + h * 128 + 2 * lane;
            const unsigned kk = *(const unsigned*)(MK + ko), vv = *(const unsigned*)(MV + ko);
            const float sc = wave_sum(q0 * bflo(kk) + q1 * bfhi(kk));
            sm_step(s, sc, bflo(vv), bfhi(vv));
        }
    } else {
        const int bs = r - MP; const float* ck = F.in[5]; const float* cv = F.in[6];
        for (int m = 0; m < NMEM; ++m) {
            const size_t ko = ((size_t)(bs * NMEM + m) * 4 + h) * 128 + 2 * lane;
            const float2 k2 = *(const float2*)(ck + ko), v2 = *(const float2*)(cv + ko);
            const float sc = wave_sum(q0 * k2.x + q1 * k2.y);
            sm_step(s, sc, v2.x, v2.y);
        }
    }
    const float il = 1.0f / s.l; const unsigned gg = *(const unsigned*)(GM + (size_t)r * WM + h * 128 + 2 * lane);
    *(unsigned*)(Z + (size_t)r * DM + 1536 + h * 128 + 2 * lane) = pk2(s.a0 * il * bflo(gg), s.a1 * il * bfhi(gg));
}
__device__ __forceinline__ void naive_hgrn_prompt_item(Frame& F, int item) {
    const int lane = F.lane; const int vb = item & 15, bh = item >> 4, h = bh % 6, b = bh / 6;
    const bf16* QB = (const bf16*)(F.ws + WS_QB); const bf16* KB = (const bf16*)(F.ws + WS_KB); const bf16* VB = (const bf16*)(F.ws + WS_VB); const float* LF = (const float*)(F.ws + WS_LF);
    float* HO = (float*)(F.ws + WS_HO);
    float S0[8], S1[8];
#pragma unroll
    for (int j = 0; j < 8; ++j) { S0[j] = 0.f; S1[j] = 0.f; }
    for (int t = 0; t < SEQ; ++t) {
        const size_t ro = (size_t)(b * SEQ + t) * WA + h * 128;
        const float qa = bf2f(QB[ro + lane]), qb = bf2f(QB[ro + lane + 64]), ka = bf2f(KB[ro + lane]), kb = bf2f(KB[ro + lane + 64]);
        const float fa = __expf(LF[ro + lane]), fb = __expf(LF[ro + lane + 64]);
        const v4u vv = *(const v4u*)(VB + ro + vb * 8);
        float v[8] = {bflo(vv.x), bfhi(vv.x), bflo(vv.y), bfhi(vv.y), bflo(vv.z), bfhi(vv.z), bflo(vv.w), bfhi(vv.w)};
        float o[8];
#pragma unroll
        for (int j = 0; j < 8; ++j) { S0[j] = fa * S0[j] + ka * v[j]; S1[j] = fb * S1[j] + kb * v[j]; o[j] = wave_sum(qa * S0[j] + qb * S1[j]); }
        if (lane == 0) { *(f32x4*)(HO + ro + vb * 8) = (f32x4){o[0], o[1], o[2], o[3]}; *(f32x4*)(HO + ro + vb * 8 + 4) = (f32x4){o[4], o[5], o[6], o[7]}; }
    }
    float* so = F.out + OUT_SP + ((size_t)bh * 128) * 128 + vb * 8;
    *(f32x4*)(so + (size_t)lane * 128) = (f32x4){S0[0], S0[1], S0[2], S0[3]}; *(f32x4*)(so + (size_t)lane * 128 + 4) = (f32x4){S0[4], S0[5], S0[6], S0[7]};
    *(f32x4*)(so + (size_t)(lane + 64) * 128) = (f32x4){S1[0], S1[1], S1[2], S1[3]}; *(f32x4*)(so + (size_t)(lane + 64) * 128 + 4) = (f32x4){S1[4], S1[5], S1[6], S1[7]};
}
__device__ __forceinline__ void hgrn_sample_item(Frame& F, int item) {
    const int lane = F.lane; const int kb = item & 7, bh = item >> 3, h = bh % 6, bs = bh / 6; const int r = MP + bs;
    const bf16* QB = (const bf16*)(F.ws + WS_QB); const bf16* KB = (const bf16*)(F.ws + WS_KB); const bf16* VB = (const bf16*)(F.ws + WS_VB); const float* LF = (const float*)(F.ws + WS_LF);
    const size_t ro = (size_t)r * WA + h * 128;
    const unsigned vv = *(const unsigned*)(VB + ro + 2 * lane); const float v0 = bflo(vv), v1 = bfhi(vv);
    const float* sp = F.in[4] + ((size_t)bh * 128 + kb * 16) * 128 + 2 * lane; float* sn = F.out + OUT_SS + ((size_t)bh * 128 + kb * 16) * 128 + 2 * lane;
    float o0 = 0.f, o1 = 0.f;
#pragma unroll 4
    for (int k = 0; k < 16; ++k) {
        const int kk = kb * 16 + k;
        const float q = bf2f(QB[ro + kk]), kf = bf2f(KB[ro + kk]), f = __expf(LF[ro + kk]);
        const float2 s = *(const float2*)(sp + (size_t)k * 128);
        const float n0 = f * s.x + kf * v0, n1 = f * s.y + kf * v1;
        *(float2*)(sn + (size_t)k * 128) = make_float2(n0, n1);
        o0 += q * n0; o1 += q * n1;
    }
    float* po = (float*)(F.ws + WS_SAMP) + ((size_t)bh * 8 + kb) * 128 + 2 * lane;
    *(float2*)po = make_float2(o0, o1);
}
__device__ __forceinline__ void hgrn_norm_task(Frame& F, int task) {
    const int lane = F.lane; const int r = task / 6, h = task % 6;
    const bf16* GB = (const bf16*)(F.ws + WS_GB); bf16* Z = (bf16*)(F.ws + WS_Z); const float* ng = F.in[11];
    float o0, o1;
    if (r < MP) { const float2 o = *(const float2*)((const float*)(F.ws + WS_HO) + (size_t)r * WA + h * 128 + 2 * lane); o0 = o.x; o1 = o.y; }
    else { const int bh = (r - MP) * 6 + h; o0 = 0.f; o1 = 0.f;
#pragma unroll
        for (int kb = 0; kb < 8; ++kb) { const float2 o = *(const float2*)((const float*)(F.ws + WS_SAMP) + ((size_t)bh * 8 + kb) * 128 + 2 * lane); o0 += o.x; o1 += o.y; } }
    const float ss = wave_sum(o0 * o0 + o1 * o1); const float rs = 1.0f / sqrtf(ss * (1.0f / 128.0f) + RMS_EPS);
    const unsigned gg = *(const unsigned*)(GB + (size_t)r * WA + h * 128 + 2 * lane); const float2 g2 = *(const float2*)(ng + h * 128 + 2 * lane);
    *(unsigned*)(Z + (size_t)r * DM + WA + h * 128 + 2 * lane) = pk2(o0 * rs * g2.x * bflo(gg), o1 * rs * g2.y * bfhi(gg));
}

__device__ __forceinline__ void sample_outproj(Frame& F) {
    const bf16* Z = (const bf16*)(F.ws + WS_Z); const bf16* WOT = (const bf16*)(F.ws + WS_WOUTT); float* RS = (float*)(F.ws + WS_RS);
    LAS float* red = (LAS float*)(F.lds + RING_OFF);
    for (int cb = F.vcu; cb < DM / 8; cb += F.G) {
        const int idx = F.tid & 255, half = F.tid >> 8, row = idx >> 3, col = cb * 8 + (idx & 7);
        const v4u* zp = (const v4u*)(Z + (size_t)(MP + row) * DM + half * 1024); const v4u* wp = (const v4u*)(WOT + (size_t)col * DM + half * 1024);
        float acc = 0.f;
        for (int k = 0; k < 128; ++k) { const v4u a = zp[k], b = wp[k];
            acc += bflo(a.x) * bflo(b.x) + bfhi(a.x) * bfhi(b.x) + bflo(a.y) * bflo(b.y) + bfhi(a.y) * bfhi(b.y) + bflo(a.z) * bflo(b.z) + bfhi(a.z) * bfhi(b.z) + bflo(a.w) * bflo(b.w) + bfhi(a.w) * bfhi(b.w); }
        __syncthreads();
        if (half == 1) red[idx] = acc;
        __syncthreads();
        if (half == 0) RS[(size_t)row * DM + col] = acc + red[idx] + DN_ALPHA * F.in[1][(size_t)row * DM + col];
    }
    __syncthreads();
}
__device__ __forceinline__ void ln_row(Frame& F, const float* rrow, float* orow) {
    const GAS f32x4* xr = (const GAS f32x4*)rrow + F.lane; const GAS f32x4* gp = (const GAS f32x4*)F.in[13] + F.lane; const GAS f32x4* bp = (const GAS f32x4*)F.in[14] + F.lane;
    f32x4 v[8]; float s = 0.f;
#pragma unroll
    for (int j = 0; j < 8; ++j) { v[j] = xr[64 * j]; s += (v[j].x + v[j].y) + (v[j].z + v[j].w); }
    const float mean = wave_sum(s) * (1.f / DM); float s2 = 0.f;
#pragma unroll
    for (int j = 0; j < 8; ++j) { v[j] = v[j] - mean; s2 += (v[j].x * v[j].x + v[j].y * v[j].y) + (v[j].z * v[j].z + v[j].w * v[j].w); }
    const float rstd = 1.f / sqrtf(wave_sum(s2) * (1.f / DM) + LN_EPS);
    GAS f32x4* op = (GAS f32x4*)orow + F.lane;
#pragma unroll
    for (int j = 0; j < 8; ++j) op[64 * j] = v[j] * rstd * gp[64 * j] + bp[64 * j];
}


typedef short v4i16_t __attribute__((ext_vector_type(4)));
typedef unsigned u32x2 __attribute__((ext_vector_type(2)));
typedef unsigned u32x4 __attribute__((ext_vector_type(4)));
__device__ __forceinline__ unsigned cvtpk(float lo, float hi) { unsigned r; asm volatile("v_cvt_pk_bf16_f32 %0, %1, %2" : "=v"(r) : "v"(lo), "v"(hi)); return r; }
__device__ __forceinline__ v4i16_t tr_read(LAS unsigned char* p) { return __builtin_amdgcn_ds_read_tr16_b64_v4i16((LAS v4i16_t*)p); }
constexpr float NEGBIG = -1e30f;
constexpr int ATT_K_OFF = 0, ATT_V_OFF = 65536;
template <bool BAND>
__device__ __forceinline__ void attn_unit(Frame& F, const bf16* kbase, const bf16* vbase, long kstride, int skip, const bf16* qbase, long qstride,
                                          bf16* obase, long ostride, float* lse, int lse_stride, const bf16* gate, long gstride) {
    constexpr int NT = BAND ? 9 : 16;
    LAS unsigned char* lds = F.lds + RING_OFF;
    const int w = F.wave, lane = F.lane, fr = lane & 15, fq = lane >> 4;
    if (skip) {
        for (int u = F.tid; u < skip * 16; u += NWAVES * 64) { *(LAS v4u*)(lds + ATT_K_OFF + u * 16) = (v4u){0u, 0u, 0u, 0u}; *(LAS v4u*)(lds + ATT_V_OFF + u * 16) = (v4u){0u, 0u, 0u, 0u}; }
    }
#pragma unroll
    for (int i = 0; i < 8; ++i) {
        const int R0 = 32 * i + 4 * w;
        if (R0 >= skip) {
            const int row = R0 + (lane >> 4), chp = lane & 15;
            const int ck = chp ^ (row & 15), cv = chp ^ (((row & 3) << 2) | (((row >> 2) & 1) << 1));
            __builtin_amdgcn_global_load_lds((const unsigned*)(kbase + (long)row * kstride + ck * 8), (LAS unsigned*)(lds + ATT_K_OFF + R0 * 256), 16, 0, 0);
            __builtin_amdgcn_global_load_lds((const unsigned*)(vbase + (long)row * kstride + cv * 8), (LAS unsigned*)(lds + ATT_V_OFF + R0 * 256), 16, 0, 0);
        }
    }
    bf16x8 qf[4];
    { const bf16* qr = qbase + (long)(16 * w + fr) * qstride + 8 * fq;
#pragma unroll
      for (int ks = 0; ks < 4; ++ks) qf[ks] = *(const bf16x8*)(qr + 32 * ks); }
    asm volatile("s_waitcnt vmcnt(0) lgkmcnt(0)" ::: "memory");
    __syncthreads();
    const int kt0 = BAND ? w : 0;
    f32x4 s[NT];
#pragma unroll
    for (int j = 0; j < NT; ++j) {
        s[j] = (f32x4){0.f, 0.f, 0.f, 0.f};
        LAS unsigned char* kp = lds + ATT_K_OFF + (16 * (kt0 + j) + fr) * 256;
#pragma unroll
        for (int ks = 0; ks < 4; ++ks) {
            const bf16x8 kf = *(const LAS bf16x8*)(kp + 16 * ((4 * ks + fq) ^ fr));
            s[j] = __builtin_amdgcn_mfma_f32_16x16x32_bf16(kf, qf[ks], s[j], 0, 0, 0);
        }
    }
    if (BAND) {
#pragma unroll
        for (int reg = 0; reg < 4; ++reg) { const int kap = 4 * fq + reg; if (kap < fr) s[0][reg] = NEGBIG; if (kap > fr) s[NT - 1][reg] = NEGBIG; }
        if (skip) {
#pragma unroll
            for (int j = 0; j < 8; ++j) if (kt0 + j < 8) s[j] = (f32x4){NEGBIG, NEGBIG, NEGBIG, NEGBIG};
        }
    }
    float mx = NEGBIG;
#pragma unroll
    for (int j = 0; j < NT; ++j) mx = fmaxf(fmaxf(mx, fmaxf(s[j][0], s[j][1])), fmaxf(s[j][2], s[j][3]));
    mx = fmaxf(mx, __shfl_xor(mx, 16)); mx = fmaxf(mx, __shfl_xor(mx, 32));
    float lsum = 0.f;
#pragma unroll
    for (int j = 0; j < NT; ++j)
#pragma unroll
        for (int reg = 0; reg < 4; ++reg) { const float p = __builtin_amdgcn_exp2f(s[j][reg] - mx); s[j][reg] = p; lsum += p; }
    lsum += __shfl_xor(lsum, 16); lsum += __shfl_xor(lsum, 32);
    f32x4 o[8];
#pragma unroll
    for (int dg = 0; dg < 8; ++dg) o[dg] = (f32x4){0.f, 0.f, 0.f, 0.f};
    const int qq = fr >> 2, pp = fr & 3, sg = (qq << 2) | ((fq & 1) << 1);
#pragma unroll
    for (int i = 0; i < (NT + 1) / 2; ++i) {
        u32x4 pb; pb.x = cvtpk(s[2 * i][0], s[2 * i][1]); pb.y = cvtpk(s[2 * i][2], s[2 * i][3]);
        if (2 * i + 1 < NT) { pb.z = cvtpk(s[2 * i + 1 < NT ? 2 * i + 1 : 0][0], s[2 * i + 1 < NT ? 2 * i + 1 : 0][1]); pb.w = cvtpk(s[2 * i + 1 < NT ? 2 * i + 1 : 0][2], s[2 * i + 1 < NT ? 2 * i + 1 : 0][3]); } else { pb.z = 0u; pb.w = 0u; }
        LAS unsigned char* vrow = lds + ATT_V_OFF + (16 * (kt0 + 2 * i) + 4 * fq + qq) * 256 + 8 * (pp & 1);
#pragma unroll
        for (int dg = 0; dg < 8; ++dg) {
            LAS unsigned char* va = vrow + 16 * ((2 * dg + (pp >> 1)) ^ sg);
            const v4i16_t lo = tr_read(va);
            v4i16_t hi = (v4i16_t){0, 0, 0, 0};
            if (2 * i + 1 < NT) hi = tr_read(va + 4096);
            const bf16x8 af = (bf16x8){lo[0], lo[1], lo[2], lo[3], hi[0], hi[1], hi[2], hi[3]};
            o[dg] = __builtin_amdgcn_mfma_f32_16x16x32_bf16(af, __builtin_bit_cast(bf16x8, pb), o[dg], 0, 0, 0);
        }
    }
    const float il = 1.0f / lsum; const int qi = 16 * w + fr;
    bf16* op = obase + (long)qi * ostride + 4 * fq;
    if (BAND) {
#pragma unroll
        for (int dg = 0; dg < 8; ++dg) { u32x2 w2; w2.x = cvtpk(o[dg][0] * il, o[dg][1] * il); w2.y = cvtpk(o[dg][2] * il, o[dg][3] * il); *(u32x2*)(op + 16 * dg) = w2; }
        if (fq == 0) lse[(long)qi * lse_stride] = mx + __log2f(lsum);
    } else {
        const bf16* gp = gate + (long)qi * gstride + 4 * fq;
#pragma unroll
        for (int dg = 0; dg < 8; ++dg) { const u32x2 g2 = *(const u32x2*)(gp + 16 * dg);
            u32x2 w2; w2.x = cvtpk(o[dg][0] * il * bflo(g2.x), o[dg][1] * il * bfhi(g2.x)); w2.y = cvtpk(o[dg][2] * il * bflo(g2.y), o[dg][3] * il * bfhi(g2.y)); *(u32x2*)(op + 16 * dg) = w2; }
    }
    __syncthreads();
}
__device__ __forceinline__ void attn_unit_dispatch(Frame& F, int u) {
    if (u < 256) {
        const int qb = u & 15, bh = u >> 4, h = bh & 3, b = bh >> 2;
        const bf16* MK = (const bf16*)(F.ws + WS_MK) + (size_t)(b * NMEM) * WM + h * 128; const bf16* MV = (const bf16*)(F.ws + WS_MV) + (size_t)(b * NMEM) * WM + h * 128;
        const size_t r0 = (size_t)b * SEQ + qb * 128;
        attn_unit<false>(F, MK, MV, WM, 0, (const bf16*)(F.ws + WS_QM) + r0 * WM + h * 128, WM, (bf16*)(F.ws + WS_Z) + r0 * DM + 1536 + h * 128, DM, nullptr, 0, (const bf16*)(F.ws + WS_GM) + r0 * WM + h * 128, WM);
    } else {
        const int v = u - 256, br = v / 384, rem = v % 384, cb = rem & 15, bh = rem >> 4, h = bh % 6, b = bh / 6;
        const int dil = br == 0 ? 1 : (br == 1 ? 4 : 16), nb = 16 / dil, cls = cb / nb, n = cb % nb;
        const long tok0 = (long)(128 * (n - 1)) * dil + cls;
        const bf16* kb = (const bf16*)(F.ws + WS_KA) + ((long)b * SEQ + tok0) * WA + h * 128; const bf16* vb = (const bf16*)(F.ws + WS_VA) + ((long)b * SEQ + tok0) * WA + h * 128;
        const long q0 = (long)b * SEQ + (long)(128 * n) * dil + cls;
        attn_unit<true>(F, kb, vb, (long)dil * WA, n == 0 ? 128 : 0, (const bf16*)(F.ws + WS_QA) + q0 * WA + h * 128, (long)dil * WA,
                        (bf16*)(F.ws + WS_OP) + ((size_t)br * MP + q0) * WA + h * 128, (long)dil * WA, (float*)(F.ws + WS_LSE) + ((size_t)br * MP + q0) * 6 + h, dil * 6, nullptr, 0);
    }
}

constexpr int H_TOT = 0, H_SSQ = 2048, H_A = 4096, H_B = H_A + 16384, H_C = H_B + 16384, H_V = H_C + 16384;
constexpr float LOG2E = 1.4426950408889634f;
__device__ __forceinline__ int sig_tr(int row) { return ((row & 3) << 2) | (((row >> 2) & 1) << 1); }
__device__ __forceinline__ void hgrn_stage_v(Frame& F, LAS unsigned char* lds, const bf16* vsrc  ) {
#pragma unroll
    for (int i = 0; i < 2; ++i) {
        const int R0 = 8 * F.wave + 4 * i, row = R0 + (F.lane >> 4), chp = F.lane & 15, cv = chp ^ sig_tr(row);
        __builtin_amdgcn_global_load_lds((const unsigned*)(vsrc + (long)row * WA + cv * 8), (LAS unsigned*)(lds + H_V + R0 * 256), 16, 0, 0);
    }
}
__device__ __forceinline__ bf16x8 tr_pair(LAS unsigned char* a) { const v4i16_t lo = tr_read(a), hi = tr_read(a + 4096); return (bf16x8){lo[0], lo[1], lo[2], lo[3], hi[0], hi[1], hi[2], hi[3]}; }
__device__ __forceinline__ void hgrn_stage1_unit(Frame& F, int unit) {
    LAS unsigned char* lds = F.lds + RING_OFF;
    const int tid = F.tid, lane = F.lane, w = F.wave, fr = lane & 15, fq = lane >> 4;
    const int c = unit & 31, bh = unit >> 5, h = bh % 6, b = bh / 6;
    const size_t row0 = (size_t)b * SEQ + 64 * c;
    const int k = tid & 127, p = tid >> 7;
    hgrn_stage_v(F, lds, (const bf16*)(F.ws + WS_VB) + row0 * WA + h * 128);
    const float* lf = (const float*)(F.ws + WS_LF) + (row0 + 16 * p) * WA + h * 128 + k;
    const bf16* kkp = (const bf16*)(F.ws + WS_KB) + (row0 + 16 * p) * WA + h * 128 + k;
    float cs[16]; unsigned short kk[16];
#pragma unroll
    for (int i = 0; i < 16; ++i) { cs[i] = lf[(size_t)i * WA]; kk[i] = kkp[(size_t)i * WA]; }
#pragma unroll
    for (int i = 1; i < 16; ++i) cs[i] += cs[i - 1];
    LAS float* tot = (LAS float*)(lds + H_TOT);
    tot[p * 128 + k] = cs[15];
    LDS_WAIT(); __syncthreads();
    const float t0 = tot[k], t1 = tot[128 + k], t2 = tot[256 + k], t3 = tot[384 + k];
    const float off = (p > 0 ? t0 : 0.f) + (p > 1 ? t1 : 0.f) + (p > 2 ? t2 : 0.f), blast = (t0 + t1) + (t2 + t3);
#pragma unroll
    for (int i = 0; i < 16; ++i) {
        const int s = 16 * p + i; const float kh = bf2f(kk[i]) * __builtin_amdgcn_exp2f((blast - (cs[i] + off)) * LOG2E);
        *(LAS unsigned short*)(lds + H_A + s * 256 + 16 * ((k >> 3) ^ sig_tr(s)) + 2 * (k & 7)) = (unsigned short)f2bf(kh);
    }
    if (p == 0) ((float*)(F.ws + WS_DC))[(size_t)unit * 128 + k] = __builtin_amdgcn_exp2f(blast * LOG2E);
    asm volatile("s_waitcnt vmcnt(0) lgkmcnt(0)" ::: "memory");
    __syncthreads();
    const int vt = w, qq = fr >> 2, pp = fr & 3, sg = (qq << 2) | ((fq & 1) << 1);
    bf16x8 vf[2];
#pragma unroll
    for (int ss = 0; ss < 2; ++ss) vf[ss] = tr_pair(lds + H_V + (32 * ss + 4 * fq + qq) * 256 + 16 * ((2 * vt + (pp >> 1)) ^ sg) + 8 * (pp & 1));
    f32x4 acc[8];
#pragma unroll
    for (int kt = 0; kt < 8; ++kt) {
        acc[kt] = (f32x4){0.f, 0.f, 0.f, 0.f};
#pragma unroll
        for (int ss = 0; ss < 2; ++ss) {
            const bf16x8 af = tr_pair(lds + H_A + (32 * ss + 4 * fq + qq) * 256 + 16 * ((2 * kt + (pp >> 1)) ^ sg) + 8 * (pp & 1));
            acc[kt] = __builtin_amdgcn_mfma_f32_16x16x32_bf16(af, vf[ss], acc[kt], 0, 0, 0);
        }
    }
    bf16* U = (bf16*)(F.ws + WS_U) + ((size_t)unit * 32 + vt * 4) * 512 + lane * 8;
#pragma unroll
    for (int ks = 0; ks < 4; ++ks) {
        u32x4 wv; wv.x = cvtpk(acc[2 * ks][0], acc[2 * ks][1]); wv.y = cvtpk(acc[2 * ks][2], acc[2 * ks][3]); wv.z = cvtpk(acc[2 * ks + 1][0], acc[2 * ks + 1][1]); wv.w = cvtpk(acc[2 * ks + 1][2], acc[2 * ks + 1][3]);
        *(u32x4*)(U + ks * 512) = wv;
    }
    __syncthreads();
}
__device__ __forceinline__ void hgrn_scan_task(Frame& F, int task) {
    const int lane = F.lane, fr = lane & 15, fq = lane >> 4; const int f = task & 31, bh = task >> 5, vt = f >> 2, ks = f & 3;
    const bf16* U = (const bf16*)(F.ws + WS_U) + ((size_t)(bh * 32) * 32 + f) * 512 + lane * 8; bf16* SP = (bf16*)(F.ws + WS_SPV) + ((size_t)(bh * 32) * 32 + f) * 512 + lane * 8;
    const float* DC = (const float*)(F.ws + WS_DC) + (size_t)(bh * 32) * 128 + 32 * ks + 4 * fq;
    float S[8];
#pragma unroll
    for (int j = 0; j < 8; ++j) S[j] = 0.f;
    for (int c0 = 0; c0 < 32; c0 += 4) {
        u32x4 u[4]; f32x4 d0[4], d1[4];
#pragma unroll
        for (int i = 0; i < 4; ++i) { u[i] = *(const u32x4*)(U + (size_t)(c0 + i) * 32 * 512); d0[i] = *(const f32x4*)(DC + (c0 + i) * 128); d1[i] = *(const f32x4*)(DC + (c0 + i) * 128 + 16); }
#pragma unroll
        for (int i = 0; i < 4; ++i) {
            u32x4 sv; sv.x = cvtpk(S[0], S[1]); sv.y = cvtpk(S[2], S[3]); sv.z = cvtpk(S[4], S[5]); sv.w = cvtpk(S[6], S[7]);
            *(u32x4*)(SP + (size_t)(c0 + i) * 32 * 512) = sv;
            S[0] = d0[i][0] * S[0] + bflo(u[i].x); S[1] = d0[i][1] * S[1] + bfhi(u[i].x); S[2] = d0[i][2] * S[2] + bflo(u[i].y); S[3] = d0[i][3] * S[3] + bfhi(u[i].y);
            S[4] = d1[i][0] * S[4] + bflo(u[i].z); S[5] = d1[i][1] * S[5] + bfhi(u[i].z); S[6] = d1[i][2] * S[6] + bflo(u[i].w); S[7] = d1[i][3] * S[7] + bfhi(u[i].w);
        }
    }
    float* so = F.out + OUT_SP + ((size_t)bh * 128 + 32 * ks + 4 * fq) * 128 + 16 * vt + fr;
#pragma unroll
    for (int j = 0; j < 4; ++j) { so[(size_t)j * 128] = S[j]; so[(size_t)(16 + j) * 128] = S[4 + j]; }
}
__device__ __forceinline__ void hgrn_stage3_unit(Frame& F, int unit) {
    LAS unsigned char* lds = F.lds + RING_OFF;
    const int tid = F.tid, lane = F.lane, w = F.wave, fr = lane & 15, fq = lane >> 4;
    const int c = unit & 31, bh = unit >> 5, h = bh % 6, b = bh / 6;
    const size_t row0 = (size_t)b * SEQ + 64 * c;
    const int k = tid & 127, p = tid >> 7;
    hgrn_stage_v(F, lds, (const bf16*)(F.ws + WS_VB) + row0 * WA + h * 128);
    const float* lf = (const float*)(F.ws + WS_LF) + (row0 + 16 * p) * WA + h * 128 + k;
    const bf16* kkp = (const bf16*)(F.ws + WS_KB) + (row0 + 16 * p) * WA + h * 128 + k; const bf16* qp = (const bf16*)(F.ws + WS_QB) + (row0 + 16 * p) * WA + h * 128 + k;
    float cs[16]; unsigned short kk[16], qv[16];
#pragma unroll
    for (int i = 0; i < 16; ++i) { cs[i] = lf[(size_t)i * WA]; kk[i] = kkp[(size_t)i * WA]; qv[i] = qp[(size_t)i * WA]; }
#pragma unroll
    for (int i = 1; i < 16; ++i) cs[i] += cs[i - 1];
    LAS float* tot = (LAS float*)(lds + H_TOT);
    tot[p * 128 + k] = cs[15];
    LDS_WAIT(); __syncthreads();
    const float t0 = tot[k], t1 = tot[128 + k], t2 = tot[256 + k];
    const float off = (p > 0 ? t0 : 0.f) + (p > 1 ? t1 : 0.f) + (p > 2 ? t2 : 0.f), bref = t0 + t1;
#pragma unroll
    for (int i = 0; i < 16; ++i) {
        const int s = 16 * p + i; const float bs = cs[i] + off, qf = bf2f(qv[i]);
        const float e1 = fminf(fmaxf((bs - bref) * LOG2E, -100.f), 100.f);
        const float qt = qf * __builtin_amdgcn_exp2f(e1), kt = bf2f(kk[i]) * __builtin_amdgcn_exp2f(-e1), qh = qf * __builtin_amdgcn_exp2f(bs * LOG2E);
        const int o = s * 256 + 16 * ((k >> 3) ^ (s & 15)) + 2 * (k & 7);
        *(LAS unsigned short*)(lds + H_A + o) = (unsigned short)f2bf(qt);
        *(LAS unsigned short*)(lds + H_B + o) = (unsigned short)f2bf(kt);
        *(LAS unsigned short*)(lds + H_C + o) = (unsigned short)f2bf(qh);
    }
    asm volatile("s_waitcnt vmcnt(0) lgkmcnt(0)" ::: "memory");
    __syncthreads();
    const int tt = w & 3, vh = w >> 2, qq = fr >> 2, pp = fr & 3, sg = (qq << 2) | ((fq & 1) << 1);
    bf16x8 qtf[4];
#pragma unroll
    for (int ks = 0; ks < 4; ++ks) qtf[ks] = *(const LAS bf16x8*)(lds + H_A + (16 * tt + fr) * 256 + 16 * ((4 * ks + fq) ^ fr));
    f32x4 at[4];
#pragma unroll
    for (int si = 0; si < 4; ++si) {
        at[si] = (f32x4){0.f, 0.f, 0.f, 0.f};
        if (si <= tt) {
#pragma unroll
            for (int ks = 0; ks < 4; ++ks) {
                const bf16x8 kf = *(const LAS bf16x8*)(lds + H_B + (16 * si + fr) * 256 + 16 * ((4 * ks + fq) ^ fr));
                at[si] = __builtin_amdgcn_mfma_f32_16x16x32_bf16(kf, qtf[ks], at[si], 0, 0, 0);
            }
            if (si == tt) {
#pragma unroll
                for (int reg = 0; reg < 4; ++reg) if (4 * fq + reg > fr) at[si][reg] = 0.f;
            }
        }
    }
    f32x4 o[4];
#pragma unroll
    for (int i = 0; i < 4; ++i) o[i] = (f32x4){0.f, 0.f, 0.f, 0.f};
#pragma unroll
    for (int sp = 0; sp < 2; ++sp) {
        if (2 * sp <= tt) {
            u32x4 pb; pb.x = cvtpk(at[2 * sp][0], at[2 * sp][1]); pb.y = cvtpk(at[2 * sp][2], at[2 * sp][3]); pb.z = cvtpk(at[2 * sp + 1][0], at[2 * sp + 1][1]); pb.w = cvtpk(at[2 * sp + 1][2], at[2 * sp + 1][3]);
#pragma unroll
            for (int i = 0; i < 4; ++i) {
                const bf16x8 vf = tr_pair(lds + H_V + (32 * sp + 4 * fq + qq) * 256 + 16 * ((2 * (4 * vh + i) + (pp >> 1)) ^ sg) + 8 * (pp & 1));
                o[i] = __builtin_amdgcn_mfma_f32_16x16x32_bf16(vf, __builtin_bit_cast(bf16x8, pb), o[i], 0, 0, 0);
            }
        }
    }
    const bf16* SP = (const bf16*)(F.ws + WS_SPV) + ((size_t)unit * 32) * 512 + lane * 8;
#pragma unroll
    for (int ks = 0; ks < 4; ++ks) {
        const int trow = 16 * tt + fr;
        const u32x2 qa = *(const LAS u32x2*)(lds + H_C + trow * 256 + 16 * ((4 * ks + (fq >> 1)) ^ fr) + 8 * (fq & 1));
        const u32x2 qb = *(const LAS u32x2*)(lds + H_C + trow * 256 + 16 * ((4 * ks + 2 + (fq >> 1)) ^ fr) + 8 * (fq & 1));
        const u32x4 qh = (u32x4){qa.x, qa.y, qb.x, qb.y};
#pragma unroll
        for (int i = 0; i < 4; ++i) {
            const bf16x8 sf = *(const bf16x8*)(SP + (size_t)((4 * vh + i) * 4 + ks) * 512);
            o[i] = __builtin_amdgcn_mfma_f32_16x16x32_bf16(sf, __builtin_bit_cast(bf16x8, qh), o[i], 0, 0, 0);
        }
    }
    float ss = 0.f;
#pragma unroll
    for (int i = 0; i < 4; ++i) ss += (o[i][0] * o[i][0] + o[i][1] * o[i][1]) + (o[i][2] * o[i][2] + o[i][3] * o[i][3]);
    ss += __shfl_xor(ss, 16); ss += __shfl_xor(ss, 32);
    LAS float* ssq = (LAS float*)(lds + H_SSQ);
    if (fq == 0) ssq[vh * 64 + 16 * tt + fr] = ss;
    LDS_WAIT(); __syncthreads();
    const float tot2 = ssq[16 * tt + fr] + ssq[64 + 16 * tt + fr];
    const float rs = 1.0f / sqrtf(tot2 * (1.0f / 128.0f) + RMS_EPS);
    const size_t row = row0 + 16 * tt + fr;
    const bf16* gb = (const bf16*)(F.ws + WS_GB) + row * WA + h * 128 + 64 * vh + 4 * fq; const float* ng = F.in[11] + h * 128 + 64 * vh + 4 * fq;
    bf16* zp = (bf16*)(F.ws + WS_Z) + row * DM + WA + h * 128 + 64 * vh + 4 * fq;
#pragma unroll
    for (int i = 0; i < 4; ++i) {
        const u32x2 g2 = *(const u32x2*)(gb + 16 * i); const f32x4 n4 = *(const f32x4*)(ng + 16 * i);
        u32x2 w2; w2.x = cvtpk(o[i][0] * rs * n4[0] * bflo(g2.x), o[i][1] * rs * n4[1] * bfhi(g2.x)); w2.y = cvtpk(o[i][2] * rs * n4[2] * bflo(g2.y), o[i][3] * rs * n4[3] * bfhi(g2.y));
        *(u32x2*)(zp + 16 * i) = w2;
    }
    __syncthreads();
}
constexpr int PSTR = 132;
constexpr size_t SAMP_HG = 0, SAMP_AT = 1 * MiB, SAMP_ME = 1 * MiB + 512 * 1024;
__device__ __forceinline__ f32x4 load_q_true(const bf16* qhead, int li) { const u32x2 w = *(const u32x2*)(qhead + 8 * (li & 15) + 4 * (li >> 4)); return (f32x4){bflo(w.x), bfhi(w.x), bflo(w.y), bfhi(w.y)}; }
__device__ __forceinline__ f32x4 load_q_nat(const bf16* qhead, int li) { const u32x2 w = *(const u32x2*)(qhead + 4 * li); return (f32x4){bflo(w.x), bfhi(w.x), bflo(w.y), bfhi(w.y)}; }
__device__ __forceinline__ void decode_seq(const f32x4 q4, const float* kb, const float* vb, long stride, int nsteps, int lane, float* rec) {
    const int hl = lane >> 5, li = lane & 31;
    const float* kp = kb + hl * stride + 4 * li; const float* vp = vb + hl * stride + 4 * li;
    float m = NEGBIG, l = 0.f; f32x4 a = (f32x4){0.f, 0.f, 0.f, 0.f};
    for (int i = 0; i < nsteps; i += 4) {
        f32x4 k[4], v[4]; float sc[4];
#pragma unroll
        for (int u = 0; u < 4; ++u) { k[u] = *(const f32x4*)(kp + (long)(2 * (i + u)) * stride); v[u] = *(const f32x4*)(vp + (long)(2 * (i + u)) * stride); }
#pragma unroll
        for (int u = 0; u < 4; ++u) sc[u] = (q4[0] * k[u][0] + q4[1] * k[u][1]) + (q4[2] * k[u][2] + q4[3] * k[u][3]);
#pragma unroll
        for (int o = 1; o < 32; o <<= 1)
#pragma unroll
            for (int u = 0; u < 4; ++u) sc[u] += __shfl_xor(sc[u], o);
#pragma unroll
        for (int u = 0; u < 4; ++u) { const float mn = fmaxf(m, sc[u]), f = __builtin_amdgcn_exp2f(m - mn), p = __builtin_amdgcn_exp2f(sc[u] - mn); l = l * f + p; a = a * f + v[u] * p; m = mn; }
    }
    const float m2 = __shfl_xor(m, 32), l2 = __shfl_xor(l, 32);
    f32x4 a2; a2[0] = __shfl_xor(a[0], 32); a2[1] = __shfl_xor(a[1], 32); a2[2] = __shfl_xor(a[2], 32); a2[3] = __shfl_xor(a[3], 32);
    const float M = fmaxf(m, m2), f1 = __builtin_amdgcn_exp2f(m - M), f2 = __builtin_amdgcn_exp2f(m2 - M);
    if (hl == 0) { *(f32x4*)(rec + 4 + 4 * li) = a * f1 + a2 * f2; if (li == 0) { rec[0] = M; rec[1] = l * f1 + l2 * f2; } }
}
__device__ __forceinline__ void sample_attn_task(Frame& F, int task) {
    const int br = task % 3, bh = task / 3, h = bh % 6, bs = bh / 6; const int dil = br == 0 ? 1 : (br == 1 ? 4 : 16);
    const f32x4 q4 = load_q_true((const bf16*)(F.ws + WS_QA) + (size_t)(MP + bs) * WA + h * 128, F.lane & 31);
    const size_t o1 = ((size_t)(bs * PASTW + PASTW - dil) * 6 + h) * 128;
    decode_seq(q4, F.in[2] + o1, F.in[3] + o1, -(long)dil * WA, 64, F.lane, (float*)(F.ws + WS_SAMP + SAMP_AT) + (size_t)task * PSTR);
}
__device__ __forceinline__ void sample_mem_task(Frame& F, int task) {
    const int half = task & 1, bh = task >> 1, h = bh & 3, bs = bh >> 2;
    const f32x4 q4 = load_q_nat((const bf16*)(F.ws + WS_QM) + (size_t)(MP + bs) * WM + h * 128, F.lane & 31);
    const size_t o1 = ((size_t)(bs * NMEM + half * 128) * 4 + h) * 128;
    decode_seq(q4, F.in[5] + o1, F.in[6] + o1, 512, 64, F.lane, (float*)(F.ws + WS_SAMP + SAMP_ME) + (size_t)task * PSTR);
}
__device__ __forceinline__ void merge_prompt_attn(Frame& F) {
    const bf16* OP = (const bf16*)(F.ws + WS_OP); const float* LSE = (const float*)(F.ws + WS_LSE); const bf16* GA = (const bf16*)(F.ws + WS_GA); bf16* Z = (bf16*)(F.ws + WS_Z);
    const int gt = F.gw * 64 + F.lane, NTH = F.NGW * 64;
    for (int idx = gt; idx < MP * 96; idx += NTH) {
        const int r = idx / 96, c8 = idx % 96, h = c8 >> 4;
        const float l0 = LSE[(size_t)r * 6 + h], l1 = LSE[((size_t)MP + r) * 6 + h], l2 = LSE[((size_t)2 * MP + r) * 6 + h];
        const float M = fmaxf(l0, fmaxf(l1, l2)); float w0 = __builtin_amdgcn_exp2f(l0 - M), w1 = __builtin_amdgcn_exp2f(l1 - M), w2 = __builtin_amdgcn_exp2f(l2 - M);
        const float inv = 1.0f / (w0 + w1 + w2); w0 *= inv; w1 *= inv; w2 *= inv;
        const size_t off = (size_t)r * WA + c8 * 8;
        const v4u a = *(const v4u*)(OP + off), b = *(const v4u*)(OP + (size_t)MP * WA + off), c = *(const v4u*)(OP + (size_t)2 * MP * WA + off), g = *(const v4u*)(GA + off);
        v4u o;
        o.x = pk2((w0 * bflo(a.x) + w1 * bflo(b.x) + w2 * bflo(c.x)) * bflo(g.x), (w0 * bfhi(a.x) + w1 * bfhi(b.x) + w2 * bfhi(c.x)) * bfhi(g.x));
        o.y = pk2((w0 * bflo(a.y) + w1 * bflo(b.y) + w2 * bflo(c.y)) * bflo(g.y), (w0 * bfhi(a.y) + w1 * bfhi(b.y) + w2 * bfhi(c.y)) * bfhi(g.y));
        o.z = pk2((w0 * bflo(a.z) + w1 * bflo(b.z) + w2 * bflo(c.z)) * bflo(g.z), (w0 * bfhi(a.z) + w1 * bfhi(b.z) + w2 * bfhi(c.z)) * bfhi(g.z));
        o.w = pk2((w0 * bflo(a.w) + w1 * bflo(b.w) + w2 * bflo(c.w)) * bflo(g.w), (w0 * bfhi(a.w) + w1 * bfhi(b.w) + w2 * bfhi(c.w)) * bfhi(g.w));
        *(v4u*)(Z + (size_t)r * DM + c8 * 8) = o;
    }
}
__device__ __forceinline__ void merge_sample_task(Frame& F, int task) {
    const int lane = F.lane, li = lane & 31; const int bs = task / 10, hh = task % 10; const int r = MP + bs;
    bf16* Z = (bf16*)(F.ws + WS_Z);
    if (hh < 6) {
        const int h = hh;
        const f32x4 q4 = load_q_true((const bf16*)(F.ws + WS_QA) + (size_t)r * WA + h * 128, li);
        const f32x4 kn = *(const f32x4*)(F.out + OUT_KS + (size_t)bs * WA + h * 128 + 4 * li), vn = *(const f32x4*)(F.out + OUT_VS + (size_t)bs * WA + h * 128 + 4 * li);
        float sn = (q4[0] * kn[0] + q4[1] * kn[1]) + (q4[2] * kn[2] + q4[3] * kn[3]);
#pragma unroll
        for (int o = 1; o < 32; o <<= 1) sn += __shfl_xor(sn, o);
        const float* rec = (const float*)(F.ws + WS_SAMP + SAMP_AT) + (size_t)((bs * 6 + h) * 3) * PSTR;
        const float m0 = rec[0], m1 = rec[PSTR], m2 = rec[2 * PSTR]; const float M = fmaxf(fmaxf(m0, m1), fmaxf(m2, sn));
        const float f0 = __builtin_amdgcn_exp2f(m0 - M), f1 = __builtin_amdgcn_exp2f(m1 - M), f2 = __builtin_amdgcn_exp2f(m2 - M), fn = 3.0f * __builtin_amdgcn_exp2f(sn - M);
        const float L = rec[1] * f0 + rec[PSTR + 1] * f1 + rec[2 * PSTR + 1] * f2 + fn;
        const f32x4 a = *(const f32x4*)(rec + 4 + 4 * li) * f0 + *(const f32x4*)(rec + PSTR + 4 + 4 * li) * f1 + *(const f32x4*)(rec + 2 * PSTR + 4 + 4 * li) * f2 + vn * fn;
        const float il = 1.0f / L; const u32x2 g = *(const u32x2*)((const bf16*)(F.ws + WS_GA) + (size_t)r * WA + h * 128 + 4 * li);
        if (lane < 32) { u32x2 o; o.x = pk2(a[0] * il * bflo(g.x), a[1] * il * bfhi(g.x)); o.y = pk2(a[2] * il * bflo(g.y), a[3] * il * bfhi(g.y)); *(u32x2*)(Z + (size_t)r * DM + h * 128 + 4 * li) = o; }
    } else {
        const int h = hh - 6;
        const float* rec = (const float*)(F.ws + WS_SAMP + SAMP_ME) + (size_t)((bs * 4 + h) * 2) * PSTR;
        const float m0 = rec[0], m1 = rec[PSTR]; const float M = fmaxf(m0, m1); const float f0 = __builtin_amdgcn_exp2f(m0 - M), f1 = __builtin_amdgcn_exp2f(m1 - M);
        const float L = rec[1] * f0 + rec[PSTR + 1] * f1;
        const f32x4 a = *(const f32x4*)(rec + 4 + 4 * li) * f0 + *(const f32x4*)(rec + PSTR + 4 + 4 * li) * f1;
        const float il = 1.0f / L; const u32x2 g = *(const u32x2*)((const bf16*)(F.ws + WS_GM) + (size_t)r * WM + h * 128 + 4 * li);
        if (lane < 32) { u32x2 o; o.x = pk2(a[0] * il * bflo(g.x), a[1] * il * bfhi(g.x)); o.y = pk2(a[2] * il * bflo(g.y), a[3] * il * bfhi(g.y)); *(u32x2*)(Z + (size_t)r * DM + 1536 + h * 128 + 4 * li) = o; }
    }
}

__global__ void __launch_bounds__(NWAVES * 64, 2) fwd_kernel(Args args) {
    extern __shared__ __attribute__((aligned(16))) unsigned char lds[];
    Frame F;
    F.lds = (LAS unsigned char*)lds;
    F.tid = threadIdx.x; F.lane = F.tid & 63; F.wave = __builtin_amdgcn_readfirstlane(F.tid >> 6);
    F.G = gridDim.x; { const int bx = blockIdx.x; F.vcu = (F.G % 8 == 0) ? (bx % 8) * (F.G / 8) + bx / 8 : bx; }
    F.gw = F.vcu * NWAVES + F.wave; F.NGW = F.G * NWAVES;
    F.ws = args.ws; F.out = args.out;
#pragma unroll
    for (int i = 0; i < 15; ++i) F.in[i] = args.in[i];
    gu32* ctl = (gu32*)(F.ws + WS_CTL);
    volatile LAS unsigned* MISC = (volatile LAS unsigned*)(F.lds + MISC_OFF);
    for (int u = F.tid; u < (LDS_BYTES - LDSCTL_OFF) / 4; u += NWAVES * 64) ((LAS unsigned*)(F.lds + LDSCTL_OFF))[u] = 0u;
    __syncthreads();
    XcdBarrier bar = xcd_barrier_post((unsigned*)(ctl + CW_BAR), MISC + 8);

    p0_prologue(F);
    xcd_barrier(bar);
    {
        pg8::Gemm g{(const pg8::bf16_t*)(F.ws + WS_XB), (const pg8::bf16_t*)(F.ws + WS_WT), MPAD + MMEM, NPROJ + 1024, DM};
        pg8::SchedProj S{F.G, (int)blockIdx.x};
        pg8::EpiProj E{F.ws, F.out};
        pg8::gemm_phase<pg8::EpiProj, pg8::SchedProj, true, true>(F.lds + RING_OFF, g, S, E);
    }
    xcd_barrier(bar);
    {
        constexpr int N_HS = MS * 6 * 8, N_SA = MS * 6 * 3, N_SM = MS * 4 * 2;
#if NAIVE_HGRN
        constexpr int N_HP = NBATCH * 6 * 16;
#else
        constexpr int N_HP = 0;
#endif
        for (int it = F.gw; it < N_HP + N_HS + N_SA + N_SM; it += F.NGW) {
            int r = it;
#if NAIVE_HGRN
            if (r < N_HP) { naive_hgrn_prompt_item(F, r); continue; } r -= N_HP;
#endif
            if (r < N_HS) { hgrn_sample_item(F, r); continue; } r -= N_HS;
            if (r < N_SA) { sample_attn_task(F, r); continue; } r -= N_SA;
            sample_mem_task(F, r);
        }
        __syncthreads();
#if NAIVE_HGRN
        for (int u = F.vcu; u < 1408; u += F.G) attn_unit_dispatch(F, u);
#else
        for (int u = F.vcu; u < 1408 + 768; u += F.G) { if (u < 1408) attn_unit_dispatch(F, u); else hgrn_stage1_unit(F, u - 1408); }
#endif
    }
    xcd_barrier(bar);
#if NAIVE_HGRN
    for (int it = F.gw; it < MTOK * 6; it += F.NGW) hgrn_norm_task(F, it);
#else
    for (int it = F.gw; it < 768; it += F.NGW) hgrn_scan_task(F, it);
    for (int it = F.gw; it < MS * 6; it += F.NGW) hgrn_norm_task(F, MP * 6 + it);
#endif
    merge_prompt_attn(F);
    for (int it = F.gw; it < MS * 10; it += F.NGW) merge_sample_task(F, it);
    xcd_barrier(bar);
#if !NAIVE_HGRN
    for (int u = F.vcu; u < 768; u += F.G) hgrn_stage3_unit(F, u);
    xcd_barrier(bar);
#endif
    {
        sample_outproj(F);
        pg8::Gemm g{(const pg8::bf16_t*)(F.ws + WS_Z), (const pg8::bf16_t*)(F.ws + WS_WOUTT), MP, DM, DM};
        pg8::StaticOrder S; S.init(MP, DM, F.G, (int)blockIdx.x);
        pg8::EpiRes E{F.in[0], F.out + OUT_Y};
        pg8::gemm_phase<pg8::EpiRes, pg8::StaticOrder, true, true>(F.lds + RING_OFF, g, S, E);
    }
    xcd_barrier(bar);
    for (int m = F.gw; m < MTOK; m += F.NGW) {
        if (m < MP) ln_row(F, F.out + OUT_Y + (size_t)m * DM, F.out + OUT_Y + (size_t)m * DM);
        else ln_row(F, (const float*)(F.ws + WS_RS) + (size_t)(m - MP) * DM, F.out + OUT_YS + (size_t)(m - MP) * DM);
    }
}

extern "C" void kernel_launch(void* const* d_in, const int* in_sizes, int n_in, void* d_out, int out_size, void* d_ws, size_t ws_size, hipStream_t stream) {
    static int grid = 0;
    if (grid == 0) {
        if (n_in != 15 || out_size != (int)OUT_TOTAL || ws_size < WS_END) { fprintf(stderr, "kernel_launch: unexpected shapes (n_in %d out %d ws %zu)\n", n_in, out_size, ws_size); grid = -1; return; }
        int dev = 0, cus = 0, per_cu = 0;
        if (hipGetDevice(&dev) != hipSuccess || hipDeviceGetAttribute(&cus, hipDeviceAttributeMultiprocessorCount, dev) != hipSuccess) { grid = -1; return; }
        if (hipFuncSetAttribute((const void*)fwd_kernel, hipFuncAttributeMaxDynamicSharedMemorySize, LDS_BYTES) != hipSuccess) { fprintf(stderr, "kernel_launch: hipFuncSetAttribute failed\n"); grid = -1; return; }
        if (hipOccupancyMaxActiveBlocksPerMultiprocessor(&per_cu, (const void*)fwd_kernel, NWAVES * 64, LDS_BYTES) != hipSuccess || per_cu < 1) { fprintf(stderr, "kernel_launch: occupancy query says %d blocks per CU\n", per_cu); per_cu = 1; }
        (void)hipGetLastError();
        grid = cus;
    }
    if (grid < 0) return;
    if (hipMemsetAsync((char*)d_ws + WS_CTL, 0, CTL_ZERO_BYTES, stream) != hipSuccess) { fprintf(stderr, "kernel_launch: memset failed\n"); return; }
    Args a{};
    for (int i = 0; i < 15; ++i) a.in[i] = (const float*)d_in[i];
    a.out = (float*)d_out; a.ws = (unsigned char*)d_ws;
    hipLaunchKernelGGL(fwd_kernel, dim3(grid), dim3(NWAVES * 64), LDS_BYTES, stream, a);
}
```

```cpp
#include <hip/hip_runtime.h>
#include <cstdio>
#include <cstdint>
#include <hip/hip_runtime.h>
#include <cstdio>
#include <cstdint>
namespace pg8 {
#define PG8_LAS __attribute__((address_space(3)))
typedef unsigned short bf16_t;
typedef short bf16x8 __attribute__((ext_vector_type(8)));
typedef float f32x4 __attribute__((ext_vector_type(4)));
typedef unsigned u32x4 __attribute__((ext_vector_type(4)));
constexpr int BM = 256, BK = 64, HALF = 128, HTB = HALF * BK * 2  , STAGE_BYTES = 8 * HTB, NXCD = 8, WGM = 8;

__host__ __device__ __forceinline__ int lds_byte(int r, int c) { const int st = (r >> 4) * 2 + (c >> 5), rr = r & 15, cc = c & 31, ob = rr * 64 + cc * 2; return st * 1024 + (ob ^ (((ob >> 9) & 1) << 5)); }
__host__ __device__ __forceinline__ void stage_rc(int b, int& R, int& C) { const int st = b / 1024, sb = b % 1024, swz = sb ^ (((sb >> 9) & 1) << 5); R = (st >> 1) * 16 + swz / 64; C = (st & 1) * 32 + (swz % 64) / 2; }
__host__ __device__ __forceinline__ int perm32(int rho) { const int n = rho >> 4, i = rho & 15; return 8 * (i >> 2) + 4 * n + (i & 3); }

struct Unit { int pm, pn; };
struct Gemm { const bf16_t* A; const bf16_t* Bt; int M, N, K; };

struct StaticOrder {
    int nM, nN, nwg, G, c;
    __host__ __device__ void init(int M, int N, int G_, int c_) { nM = M / BM; nN = N / BM; nwg = nM * nN; G = G_; c = c_; }
    __host__ __device__ bool next(int i, Unit& u) const {
        const long L = (long)i * G + c; if (L >= nwg) return false;
        int wgid = (int)L; { const int q = nwg / NXCD, r = nwg % NXCD, xcd = wgid % NXCD, off = wgid / NXCD; wgid = (xcd < r ? xcd * (q + 1) : r * (q + 1) + (xcd - r) * q) + off; }
        const int nig = WGM * nN, gid = wgid / nig, fm = gid * WGM, gsz = (nM - fm) < WGM ? (nM - fm) : WGM;
        u.pm = fm + ((wgid % nig) % gsz); u.pn = (wgid % nig) / gsz; return true;
    }
    __device__ __forceinline__ void a_ready(const Unit&) const {}
    __device__ __forceinline__ void done(const Unit&) const {}
};

typedef float f32x2c_t __attribute__((ext_vector_type(2))); typedef __bf16 bf16x2c_t __attribute__((ext_vector_type(2)));
__device__ __forceinline__ unsigned cvt_pk_bf16(float lo, float hi) { const f32x2c_t v = {lo, hi}; const bf16x2c_t b = __builtin_convertvector(v, bf16x2c_t); return __builtin_bit_cast(unsigned, b); }
typedef float f32x2 __attribute__((ext_vector_type(2)));
__device__ __forceinline__ f32x2 gelu_pk(f32x2 v) {
    const f32x2 av = __builtin_elementwise_abs(v), d = av * 0.2316418882f + 1.0f;
    f32x2 t; t.x = __builtin_amdgcn_rcpf(d.x); t.y = __builtin_amdgcn_rcpf(d.y);
    f32x2 q = t * 0.5307027145f + (-0.7265760135f); q = q * t + 0.7107068705f; q = q * t + (-0.142248368f); q = q * t + 0.127414796f; q = q * t;
    const f32x2 s = (v * v) * (-0.72134752044f);
    f32x2 e; e.x = __builtin_amdgcn_exp2f(s.x); e.y = __builtin_amdgcn_exp2f(s.y);
    const f32x2 m = v * (q * e), r = v - m;
    f32x2 o; o.x = v.x < 0.f ? m.x : r.x; o.y = v.y < 0.f ? m.y : r.y; return o;
}

template <int ACT  > struct EpiBf16 {
    static constexpr bool PERM = true, AFTER_DRAIN = false; static_assert(ACT == 0 || ACT == 1, "EpiBf16: ACT is 0 (none) or 1 (gelu_pk)");
    bf16_t* O; int ldc; const float* bias; int split_cols; size_t split_stride; float scale0;
    __device__ __forceinline__ void operator()(const f32x4 (&acc)[2][2][4][2], const Unit& u, int wr, int wc, int fr, int fq) const {
        const int row0 = u.pm * BM + wr * 64 + fr; int colt = u.pn * BM; bf16_t* base = O;
        float sc = 1.f; if (split_cols) { const int t = colt / split_cols; base += (size_t)t * split_stride; colt -= t * split_cols; if (t == 0) sc = scale0; }
        const int col0 = colt + wc * 32 + 8 * fq, bcol0 = u.pn * BM + wc * 32 + 8 * fq;
        f32x4 bv[2][2];
#pragma unroll
        for (int bj = 0; bj < 2; ++bj)
#pragma unroll
            for (int n = 0; n < 2; ++n) bv[bj][n] = bias ? *(const f32x4*)(bias + bcol0 + bj * HALF + 4 * n) : (f32x4){0.f, 0.f, 0.f, 0.f};
#pragma unroll
        for (int ai = 0; ai < 2; ++ai)
#pragma unroll
            for (int m = 0; m < 4; ++m) { bf16_t* rowp = base + (size_t)(row0 + ai * HALF + m * 16) * ldc + col0;
#pragma unroll
                for (int bj = 0; bj < 2; ++bj) { f32x4 v0 = acc[ai][bj][m][0] + bv[bj][0], v1 = acc[ai][bj][m][1] + bv[bj][1];
                    if (ACT == 1) { f32x2 a = gelu_pk((f32x2){v0[0], v0[1]}), b = gelu_pk((f32x2){v0[2], v0[3]}), c = gelu_pk((f32x2){v1[0], v1[1]}), d = gelu_pk((f32x2){v1[2], v1[3]});
                        v0 = (f32x4){a.x, a.y, b.x, b.y}; v1 = (f32x4){c.x, c.y, d.x, d.y}; }
                    v0 = v0 * sc; v1 = v1 * sc; u32x4 w; w.x = cvt_pk_bf16(v0[0], v0[1]); w.y = cvt_pk_bf16(v0[2], v0[3]); w.z = cvt_pk_bf16(v1[0], v1[1]); w.w = cvt_pk_bf16(v1[2], v1[3]);
                    *(u32x4*)(rowp + bj * HALF) = w; } }
    }
};

struct PanelStats {
    unsigned* xbuf;
    unsigned* cnt;
    unsigned* tmo;
    int ntn; float eps;
    unsigned code;
    __device__ __forceinline__ bool run(const f32x4 (&v)[2][2][4][2], const Unit& u, int wr, int wc, int fr, int fq, PG8_LAS unsigned char* lds, int wid, int lane) const {
        typedef float f32x2v __attribute__((ext_vector_type(2)));
        PG8_LAS f32x2v* P = (PG8_LAS f32x2v*)lds;
        PG8_LAS f32x2v* S = (PG8_LAS f32x2v*)(lds + 8192);
        PG8_LAS unsigned* flag = (PG8_LAS unsigned*)(lds + 8192 + 2048);
#pragma unroll
        for (int ai = 0; ai < 2; ++ai)
#pragma unroll
            for (int m = 0; m < 4; ++m) {
                float s = 0.f;
#pragma unroll
                for (int bj = 0; bj < 2; ++bj)
#pragma unroll
                    for (int n = 0; n < 2; ++n) { const f32x4 x = v[ai][bj][m][n]; s += (x[0] + x[1]) + (x[2] + x[3]); }
                s += __shfl_xor(s, 16); s += __shfl_xor(s, 32);
                const float mw = s * (1.0f / 64.0f); float q = 0.f;
#pragma unroll
                for (int bj = 0; bj < 2; ++bj)
#pragma unroll
                    for (int n = 0; n < 2; ++n) { const f32x4 d = v[ai][bj][m][n] - mw; q += (d[0] * d[0] + d[1] * d[1]) + (d[2] * d[2] + d[3] * d[3]); }
                q += __shfl_xor(q, 16); q += __shfl_xor(q, 32);
                if (fq == 0) P[(ai * HALF + wr * 64 + m * 16 + fr) * 4 + wc] = (f32x2v){mw, q};
            }
        asm volatile("s_waitcnt lgkmcnt(0)" ::: "memory"); __builtin_amdgcn_s_barrier(); asm volatile("" ::: "memory");
#if defined(BROKEN_EXCHANGE_NO_WAIT)
#warning BROKEN CONTROL BUILD: the row-statistics exchange does not wait; results are wrong by design
        if (blockIdx.x >= 64) { const long long t0_ = clock64(); while (clock64() - t0_ < 60000) __builtin_amdgcn_s_sleep(8); }
#endif
        const int row = wid * 32 + (lane & 31);
        if (lane < 32) {
            const f32x2v a = P[row * 4 + 0], b = P[row * 4 + 1], c = P[row * 4 + 2], d = P[row * 4 + 3];
            const float mt = (a.x + b.x + c.x + d.x) * 0.25f;
            const float da = a.x - mt, db = b.x - mt, dc = c.x - mt, dd = d.x - mt;
            const float m2 = (a.y + b.y) + (c.y + d.y) + 64.0f * ((da * da + db * db) + (dc * dc + dd * dd));
            unsigned long long* slot = (unsigned long long*)xbuf + ((size_t)(u.pm * BM + row) * 4 + u.pn);
            __hip_atomic_store(slot, ((unsigned long long)__float_as_uint(m2) << 32) | __float_as_uint(mt), __ATOMIC_RELAXED, __HIP_MEMORY_SCOPE_AGENT);
        }
        asm volatile("s_waitcnt vmcnt(0)" ::: "memory");
        if (lane == 0) __hip_atomic_fetch_add(cnt + 64 * u.pm, 1u, __ATOMIC_RELAXED, __HIP_MEMORY_SCOPE_AGENT);
        if (wid == 0) {
            bool dead = false; const unsigned long long t0 = __builtin_amdgcn_s_memrealtime(); const unsigned want = 8u * (unsigned)ntn;
            for (;;) {
#if defined(BROKEN_EXCHANGE_NO_WAIT)
                break;
#endif
                if ((unsigned)__builtin_amdgcn_readfirstlane(__hip_atomic_load(cnt + 64 * u.pm, __ATOMIC_RELAXED, __HIP_MEMORY_SCOPE_AGENT)) >= want) break;
                if (__builtin_amdgcn_s_memrealtime() - t0 > 2000000ull) {
                    if (lane == 0) { unsigned expect = 0u; __hip_atomic_compare_exchange_strong(tmo + 1, &expect, code | (unsigned)(u.pm & 0xff), __ATOMIC_RELAXED, __ATOMIC_RELAXED, __HIP_MEMORY_SCOPE_AGENT);
                                     __hip_atomic_store(tmo, 1u, __ATOMIC_RELAXED, __HIP_MEMORY_SCOPE_AGENT); }
                    dead = true; break; }
                __builtin_amdgcn_s_sleep(2);
            }
            __builtin_amdgcn_fence(__ATOMIC_ACQUIRE, "agent");
            if (lane == 0) flag[0] = dead ? 1u : 0u;
        }
        asm volatile("s_waitcnt vmcnt(0) lgkmcnt(0)" ::: "memory"); __builtin_amdgcn_s_barrier(); asm volatile("" ::: "memory");
        const bool bad = flag[0] != 0u;
        if (lane < 32) {
            const unsigned long long* slot = (const unsigned long long*)xbuf + (size_t)(u.pm * BM + row) * 4; float mt[4], m2[4]; float ms = 0.f;
#pragma unroll
            for (int t = 0; t < 4; ++t) { if (t < ntn) { const unsigned long long w = __hip_atomic_load(slot + t, __ATOMIC_RELAXED, __HIP_MEMORY_SCOPE_AGENT); mt[t] = __uint_as_float((unsigned)w); m2[t] = __uint_as_float((unsigned)(w >> 32)); } else { mt[t] = 0.f; m2[t] = 0.f; } ms += mt[t]; }
            const float mean = ms / (float)ntn; float q = 0.f;
#pragma unroll
            for (int t = 0; t < 4; ++t) if (t < ntn) { const float dm = mt[t] - mean; q += m2[t] + 256.0f * dm * dm; }
            S[row] = (f32x2v){mean, 1.0f / sqrtf(q / (256.0f * (float)ntn) + eps)};
        }
        asm volatile("s_waitcnt lgkmcnt(0)" ::: "memory"); __builtin_amdgcn_s_barrier(); asm volatile("" ::: "memory");
        return bad;
    }
};
struct EpiLnRes {
    static constexpr bool PERM = false, AFTER_DRAIN = true;
    const float* base; float* out; int ldc; const float* bias; PanelStats st; unsigned poison;
    __device__ __forceinline__ void fused(f32x4 (&acc)[2][2][4][2], const Unit& u, int wr, int wc, int fr, int fq, PG8_LAS unsigned char* lds, int wid, int lane) const {
        typedef float f32x2v __attribute__((ext_vector_type(2)));
        const PG8_LAS f32x2v* S = (const PG8_LAS f32x2v*)(lds + 8192);
        const int col0 = u.pn * BM + wc * 32 + 4 * fq;
#pragma unroll
        for (int bj = 0; bj < 2; ++bj)
#pragma unroll
            for (int n = 0; n < 2; ++n) { const f32x4 bv = bias ? *(const f32x4*)(bias + col0 + bj * HALF + n * 16) : (f32x4){0.f, 0.f, 0.f, 0.f};
#pragma unroll
                for (int ai = 0; ai < 2; ++ai)
#pragma unroll
                    for (int m = 0; m < 4; ++m) acc[ai][bj][m][n] += bv; }
        f32x4 pre[4][2][2];
#pragma unroll
        for (int m = 0; m < 4; ++m) { const size_t off = (size_t)(u.pm * BM + wr * 64 + m * 16 + fr) * ldc + col0;
#pragma unroll
            for (int bj = 0; bj < 2; ++bj)
#pragma unroll
                for (int n = 0; n < 2; ++n) pre[m][bj][n] = *(const f32x4*)(base + off + bj * HALF + n * 16); }
        const bool bad = st.run(acc, u, wr, wc, fr, fq, lds, wid, lane) || poison != 0u;
        const float qnan = __builtin_nanf("");
#pragma unroll
        for (int ai = 0; ai < 2; ++ai)
#pragma unroll
            for (int m = 0; m < 4; ++m) { const int r = ai * HALF + wr * 64 + m * 16 + fr; const f32x2v sr = S[r]; const size_t off = (size_t)(u.pm * BM + r) * ldc + col0;
#pragma unroll
                for (int bj = 0; bj < 2; ++bj)
#pragma unroll
                    for (int n = 0; n < 2; ++n) { const f32x4 bs = ai == 0 ? pre[m][bj][n] : *(const f32x4*)(base + off + bj * HALF + n * 16); f32x4 o = bs + (acc[ai][bj][m][n] - sr.x) * sr.y;
                        if (bad) o = (f32x4){qnan, qnan, qnan, qnan}; *(f32x4*)(out + off + bj * HALF + n * 16) = o; }
                if (m & 1) asm volatile("" ::: "memory"); }
    }
};
struct EpiLnResLn {
    static constexpr bool PERM = false, AFTER_DRAIN = true;
    const float* base; float* out; bf16_t* xn; int ldc; const float* bias; PanelStats st1, st2; unsigned poison;
    __device__ __forceinline__ void fused(f32x4 (&acc)[2][2][4][2], const Unit& u, int wr, int wc, int fr, int fq, PG8_LAS unsigned char* lds, int wid, int lane) const {
        typedef float f32x2v __attribute__((ext_vector_type(2))); typedef unsigned u32x2v __attribute__((ext_vector_type(2)));
        const PG8_LAS f32x2v* S = (const PG8_LAS f32x2v*)(lds + 8192);
        const int col0 = u.pn * BM + wc * 32 + 4 * fq;
#pragma unroll
        for (int bj = 0; bj < 2; ++bj)
#pragma unroll
            for (int n = 0; n < 2; ++n) { const f32x4 bv = bias ? *(const f32x4*)(bias + col0 + bj * HALF + n * 16) : (f32x4){0.f, 0.f, 0.f, 0.f};
#pragma unroll
                for (int ai = 0; ai < 2; ++ai)
#pragma unroll
                    for (int m = 0; m < 4; ++m) acc[ai][bj][m][n] += bv; }
        bool bad = st1.run(acc, u, wr, wc, fr, fq, lds, wid, lane) || poison != 0u;
        const float qnan = __builtin_nanf("");
#pragma unroll
        for (int ai = 0; ai < 2; ++ai)
#pragma unroll
            for (int m = 0; m < 4; ++m) { const int r = ai * HALF + wr * 64 + m * 16 + fr; const f32x2v sr = S[r]; const size_t off = (size_t)(u.pm * BM + r) * ldc + col0;
#pragma unroll
                for (int bj = 0; bj < 2; ++bj)
#pragma unroll
                    for (int n = 0; n < 2; ++n) { const f32x4 bs = *(const f32x4*)(base + off + bj * HALF + n * 16); acc[ai][bj][m][n] = bs + (acc[ai][bj][m][n] - sr.x) * sr.y; }
                asm volatile("" : "+v"(acc[ai][0][m][0]), "+v"(acc[ai][0][m][1]), "+v"(acc[ai][1][m][0]), "+v"(acc[ai][1][m][1]));
                if (m & 1) asm volatile("" ::: "memory"); }
        const bool bad1 = bad;
        bad = st2.run(acc, u, wr, wc, fr, fq, lds, wid, lane) || bad;
#pragma unroll
        for (int ai = 0; ai < 2; ++ai)
#pragma unroll
            for (int m = 0; m < 4; ++m) { const int r = ai * HALF + wr * 64 + m * 16 + fr; const f32x2v sr = S[r]; const size_t off = (size_t)(u.pm * BM + r) * ldc + col0;
#pragma unroll
                for (int bj = 0; bj < 2; ++bj)
#pragma unroll
                    for (int n = 0; n < 2; ++n) { const f32x4 x1 = acc[ai][bj][m][n]; *(f32x4*)(out + off + bj * HALF + n * 16) = bad1 ? (f32x4){qnan, qnan, qnan, qnan} : x1;
                        const f32x4 o = (x1 - sr.x) * sr.y; u32x2v w; w.x = cvt_pk_bf16(o[0], o[1]); w.y = cvt_pk_bf16(o[2], o[3]);
                        if (bad) { w.x = 0x7fc07fc0u; w.y = 0x7fc07fc0u; } *(u32x2v*)(xn + off + bj * HALF + n * 16) = w; }
                asm volatile("" ::: "memory"); }
    }
};

template <class Epi, class Sched, bool ALIGN_EPI = false, bool SP2 = false>
__device__ __forceinline__ void gemm_phase(PG8_LAS unsigned char* lds, const Gemm g, const Sched& S, const Epi& E) {
    const int tid = threadIdx.x, wid = __builtin_amdgcn_readfirstlane(tid >> 6), lane = tid & 63, wr = wid >> 2, wc = wid & 3, fr = lane & 15, fq = lane >> 4;
    const int K = g.K, nt = K / BK;
    unsigned voffA[2], voffB[2];
#pragma unroll
    for (int i = 0; i < 2; ++i) { int R, C; stage_rc(tid * 16 + i * 8192, R, C); const int Rb = Epi::PERM ? ((R & ~31) + perm32(R & 31)) : R;
        voffA[i] = (unsigned)(R * K + C) * 2u; voffB[i] = (unsigned)(Rb * K + C) * 2u; }
    const size_t kstep = (size_t)(BK * 2);
    const size_t hstep = (size_t)HALF * K * 2;
    const size_t tstep = 2 * hstep;
    const unsigned ldsw = (unsigned)wid * 1024u;
    const int aoff = lds_byte(wr * 64 + fr, fq * 8), boff = lds_byte(wc * 32 + fr, fq * 8);
#define PG8_SA(b, h) (((b) * 2 + (h)) * HTB)
#define PG8_SB(b, h) ((4 + (b) * 2 + (h)) * HTB)
#define PG8_STAGE(bufoff, gbase, voff) do { _Pragma("unroll") for (int _i = 0; _i < 2; ++_i) \
        __builtin_amdgcn_global_load_lds((const unsigned*)((const char*)(gbase) + (voff)[_i]), (PG8_LAS unsigned*)(lds + (bufoff) + ldsw + _i * 8192), 16, 0, 0); } while (0)
#define PG8_LDA(dst, b, h) do { _Pragma("unroll") for (int m = 0; m < 4; ++m) _Pragma("unroll") for (int k = 0; k < 2; ++k) dst[m][k] = *(const PG8_LAS bf16x8*)(lds + PG8_SA(b, h) + aoff + m * 2048 + k * 1024); } while (0)
#define PG8_LDB(dst, b, h) do { _Pragma("unroll") for (int n = 0; n < 2; ++n) _Pragma("unroll") for (int k = 0; k < 2; ++k) dst[n][k] = *(const PG8_LAS bf16x8*)(lds + PG8_SB(b, h) + boff + n * 2048 + k * 1024); } while (0)
#define PG8_MMA(ai, bj, At, Bt) do { __builtin_amdgcn_s_setprio(1); _Pragma("unroll") for (int m = 0; m < 4; ++m) _Pragma("unroll") for (int n = 0; n < 2; ++n) _Pragma("unroll") for (int k = 0; k < 2; ++k) \
        acc[ai][bj][m][n] = __builtin_amdgcn_mfma_f32_16x16x32_bf16(Bt[n][k], At[m][k], acc[ai][bj][m][n], 0, 0, 0); __builtin_amdgcn_s_setprio(0); } while (0)
#define PG8_WAIT_V(n) asm volatile("s_waitcnt vmcnt(" #n ")" ::: "memory")
#define PG8_WAIT_L(n) asm volatile("s_waitcnt lgkmcnt(" #n ")" ::: "memory")
#define PG8_BAR __builtin_amdgcn_s_barrier()
#define PG8_SCHED __builtin_amdgcn_sched_barrier(0)
    Unit cur, nxt; int ui = 0;
    if (!S.next(0, cur)) return;
    f32x4 acc[2][2][4][2];
#pragma unroll
    for (int a = 0; a < 2; ++a)
#pragma unroll
        for (int b = 0; b < 2; ++b)
#pragma unroll
            for (int m = 0; m < 4; ++m)
#pragma unroll
                for (int n = 0; n < 2; ++n) acc[a][b][m][n] = (f32x4){0.f, 0.f, 0.f, 0.f};
    bf16x8 At[4][2], B0[2][2], B1[2][2];
    const char* cA = (const char*)g.A + (size_t)cur.pm * tstep; const char* cB = (const char*)g.Bt + (size_t)cur.pn * tstep;
    S.a_ready(cur);
    if constexpr (SP2) {
        PG8_STAGE(PG8_SB(0, 0), cB, voffB); PG8_STAGE(PG8_SB(0, 1), cB + hstep, voffB); PG8_STAGE(PG8_SA(0, 0), cA, voffA); PG8_STAGE(PG8_SA(0, 1), cA + hstep, voffA);
        if (wr == 1) PG8_BAR;
        PG8_WAIT_V(2); PG8_BAR;
        PG8_STAGE(PG8_SB(1, 0), cB + kstep, voffB); PG8_STAGE(PG8_SA(1, 0), cA + kstep, voffA); PG8_STAGE(PG8_SB(1, 1), cB + hstep + kstep, voffB);
        PG8_WAIT_V(6); PG8_BAR;
    } else {
        PG8_STAGE(PG8_SB(0, 0), cB, voffB); PG8_STAGE(PG8_SA(0, 0), cA, voffA); PG8_STAGE(PG8_SB(0, 1), cB + hstep, voffB); PG8_STAGE(PG8_SA(0, 1), cA + hstep, voffA);
        if (wr == 1) PG8_BAR;
        PG8_WAIT_V(4); PG8_BAR;
        PG8_STAGE(PG8_SB(1, 0), cB + kstep, voffB); PG8_STAGE(PG8_SA(1, 0), cA + kstep, voffA); PG8_STAGE(PG8_SB(1, 1), cB + hstep + kstep, voffB);
        PG8_WAIT_V(6); PG8_BAR;
    }
    for (;;) {
        const bool has_next = S.next(ui + 1, nxt);
        const char* nA = has_next ? (const char*)g.A + (size_t)nxt.pm * tstep : cA; const char* nB = has_next ? (const char*)g.Bt + (size_t)nxt.pn * tstep : cB;
        for (int t = 0; t < nt; t += 2) {
            const bool last = (t == nt - 2);
            const char* a1 = cA + (size_t)(t + 1) * kstep;
            const char* a2 = last ? nA : cA + (size_t)(t + 2) * kstep; const char* b2 = last ? nB : cB + (size_t)(t + 2) * kstep;
            const char* a3 = a2 + kstep; const char* b3 = b2 + kstep;
            if (last && has_next) S.a_ready(nxt);
            if constexpr (SP2) {
            PG8_LDB(B0, 0, 0); PG8_LDB(B1, 0, 1); PG8_SCHED; PG8_LDA(At, 0, 0); PG8_STAGE(PG8_SA(1, 1), a1 + hstep, voffA);
            PG8_WAIT_V(8); PG8_WAIT_L(0); PG8_BAR; PG8_MMA(0, 0, At, B0); PG8_MMA(0, 1, At, B1); PG8_BAR; PG8_SCHED;
            PG8_LDA(At, 0, 1); PG8_STAGE(PG8_SB(0, 0), b2, voffB); PG8_STAGE(PG8_SB(0, 1), b2 + hstep, voffB); PG8_STAGE(PG8_SA(0, 0), a2, voffA);
            PG8_WAIT_V(8); PG8_WAIT_L(0); PG8_BAR; PG8_MMA(1, 0, At, B0); PG8_MMA(1, 1, At, B1); PG8_BAR; PG8_SCHED;
            PG8_LDB(B0, 1, 0); PG8_LDB(B1, 1, 1); PG8_SCHED; PG8_LDA(At, 1, 0); PG8_STAGE(PG8_SA(0, 1), a2 + hstep, voffA);
            PG8_WAIT_V(8); PG8_WAIT_L(0); PG8_BAR; PG8_MMA(0, 0, At, B0); PG8_MMA(0, 1, At, B1); PG8_BAR; PG8_SCHED;
            PG8_LDA(At, 1, 1); PG8_STAGE(PG8_SB(1, 0), b3, voffB); PG8_STAGE(PG8_SB(1, 1), b3 + hstep, voffB); PG8_STAGE(PG8_SA(1, 0), a3, voffA);
            PG8_WAIT_V(8); PG8_WAIT_L(0); PG8_BAR; PG8_MMA(1, 0, At, B0); PG8_MMA(1, 1, At, B1); PG8_BAR; PG8_SCHED;
            } else {
            PG8_LDB(B0, 0, 0); PG8_SCHED; PG8_LDA(At, 0, 0); PG8_STAGE(PG8_SA(1, 1), a1 + hstep, voffA);
            PG8_WAIT_L(8); PG8_BAR; PG8_WAIT_L(0); PG8_MMA(0, 0, At, B0); PG8_BAR; PG8_SCHED;
            PG8_LDB(B1, 0, 1); PG8_STAGE(PG8_SB(0, 0), b2, voffB);
            PG8_BAR; PG8_WAIT_L(0); PG8_MMA(0, 1, At, B1); PG8_BAR;
            PG8_LDA(At, 0, 1); PG8_STAGE(PG8_SA(0, 0), a2, voffA);
            PG8_BAR; PG8_WAIT_L(0); PG8_MMA(1, 0, At, B0); PG8_BAR; PG8_SCHED;
            PG8_STAGE(PG8_SB(0, 1), b2 + hstep, voffB);
            PG8_WAIT_V(6); PG8_BAR; PG8_MMA(1, 1, At, B1); PG8_BAR;
            PG8_LDB(B0, 1, 0); PG8_SCHED; PG8_LDA(At, 1, 0); PG8_STAGE(PG8_SA(0, 1), a2 + hstep, voffA);
            PG8_WAIT_L(8); PG8_BAR; PG8_WAIT_L(0); PG8_MMA(0, 0, At, B0); PG8_BAR; PG8_SCHED;
            PG8_LDB(B1, 1, 1); PG8_STAGE(PG8_SB(1, 0), b3, voffB);
            PG8_BAR; PG8_WAIT_L(0); PG8_MMA(0, 1, At, B1); PG8_BAR;
            PG8_LDA(At, 1, 1); PG8_STAGE(PG8_SA(1, 0), a3, voffA);
            PG8_BAR; PG8_WAIT_L(0); PG8_MMA(1, 0, At, B0); PG8_BAR; PG8_SCHED;
            PG8_STAGE(PG8_SB(1, 1), b3 + hstep, voffB);
            PG8_WAIT_V(6); PG8_BAR; PG8_MMA(1, 1, At, B1); PG8_BAR;
            }
        }
        if constexpr (ALIGN_EPI) { if (wr == 0) PG8_BAR; }
        if constexpr (!Epi::AFTER_DRAIN) { E(acc, cur, wr, wc, fr, fq); S.done(cur); }
        if (!has_next) break;
#pragma unroll
        for (int a = 0; a < 2; ++a)
#pragma unroll
            for (int b = 0; b < 2; ++b)
#pragma unroll
                for (int m = 0; m < 4; ++m)
#pragma unroll
                    for (int n = 0; n < 2; ++n) acc[a][b][m][n] = (f32x4){0.f, 0.f, 0.f, 0.f};
        cur = nxt; cA = nA; cB = nB; ++ui;
        if constexpr (ALIGN_EPI) { if (wr == 1) PG8_BAR; }
    }
    PG8_WAIT_V(0);
    if constexpr (!ALIGN_EPI) { if (wr == 0) PG8_BAR; }
    PG8_BAR;
    if constexpr (Epi::AFTER_DRAIN) { E.fused(acc, cur, wr, wc, fr, fq, lds, wid, lane); S.done(cur); }
#undef PG8_SA
#undef PG8_SB
#undef PG8_STAGE
#undef PG8_LDA
#undef PG8_LDB
#undef PG8_MMA
#undef PG8_WAIT_V
#undef PG8_WAIT_L
#undef PG8_BAR
#undef PG8_SCHED
}
}
#define GAS __attribute__((address_space(1)))
#define LAS __attribute__((address_space(3)))
typedef unsigned short bf16;
typedef unsigned v4u __attribute__((ext_vector_type(4)));
typedef float f32x4 __attribute__((ext_vector_type(4)));
typedef short bf16x8 __attribute__((ext_vector_type(8)));
typedef GAS unsigned gu32;
typedef GAS unsigned long long gu64;
#define RLX_AGENT __ATOMIC_RELAXED, __HIP_MEMORY_SCOPE_AGENT
#define LDS_WAIT() asm volatile("s_waitcnt lgkmcnt(0)" ::: "memory")
#define VM_WAIT() asm volatile("s_waitcnt vmcnt(0)" ::: "memory")
__device__ __forceinline__ unsigned long long rt() { return __builtin_amdgcn_s_memrealtime(); }
__device__ __forceinline__ unsigned f2bf(float f) { unsigned u = __builtin_bit_cast(unsigned, f); return (u + 0x7fffu + ((u >> 16) & 1u)) >> 16; }
__device__ __forceinline__ unsigned pk2(float lo, float hi) { return f2bf(lo) | (f2bf(hi) << 16); }

#define XB_TMO      128
#define XB_XCNT(j)  (256  + 64 * (j))
#define XB_XSUB(j)  (1280 + 64 * (j))
#define XB_XGEN(j)  (2304 + 64 * (j))
#define XB_TOP      3328
#define XB_TOPGEN   3392
#define XCD_BAR_WORDS 3456
#define XB_SPIN_CAP (1u << 18)

__device__ __forceinline__ unsigned xb_ld(unsigned* p)              { return __hip_atomic_load(p, __ATOMIC_RELAXED, __HIP_MEMORY_SCOPE_AGENT); }
__device__ __forceinline__ unsigned xb_add(unsigned* p, unsigned v) { return __hip_atomic_fetch_add(p, v, __ATOMIC_RELAXED, __HIP_MEMORY_SCOPE_AGENT); }
__device__ __forceinline__ unsigned xb_xcc_id() { return (unsigned)__builtin_amdgcn_s_getreg((3 << 11) | 20) & 0xFu; }
#define XB_SPIN(cond, bar) do { unsigned _sp = 0; while (cond) { __builtin_amdgcn_s_sleep(1); \
    if ((++_sp & 255u) == 0u) { if (xb_ld(&(bar)[XB_TMO])) break; if (_sp > XB_SPIN_CAP) { atomicAdd(&(bar)[XB_TMO], 1u); break; } } } } while (0)

struct XcdBarrier {
    unsigned* bar; unsigned x;
    volatile LAS unsigned* st;
};

__device__ __forceinline__ XcdBarrier xcd_barrier_post(unsigned* bar, volatile LAS unsigned* st) {
    XcdBarrier b; b.bar = bar; b.x = xb_xcc_id(); b.st = st;
    if (threadIdx.x == 0) (void)xb_add(&bar[XB_XCNT(b.x)], 1u);
    return b;
}
__device__ __forceinline__ void xcd_barrier_complete(unsigned* bar, unsigned x, unsigned& nloc, unsigned& nx) {
    const unsigned G = gridDim.x * gridDim.y * gridDim.z;
    unsigned sum, cnt, mine, sp = 0u;
    for (;;) {
        sum = 0u; cnt = 0u; mine = 0u;
#pragma unroll
        for (unsigned j = 0; j < 16; ++j) { const unsigned c = xb_ld(&bar[XB_XCNT(j)]); sum += c; cnt += (c > 0u) ? 1u : 0u; mine = (j == x) ? c : mine; }
        if (sum == G) break;
        __builtin_amdgcn_s_sleep(1);
        if ((++sp & 255u) == 0u) { if (xb_ld(&bar[XB_TMO])) break; if (sp > XB_SPIN_CAP) { atomicAdd(&bar[XB_TMO], 1u); break; } }
    }
    nloc = mine > 0u ? mine : 1u; nx = cnt > 0u ? cnt : 1u;
}

__device__ __forceinline__ void xcd_barrier(const XcdBarrier& b) {
    asm volatile("s_waitcnt vmcnt(0)" ::: "memory");
    __syncthreads();
    if (threadIdx.x == 0) {
        unsigned* bar = b.bar;
        __builtin_amdgcn_s_waitcnt(0);
        unsigned nloc = b.st[0], nx = b.st[1];
        if (nloc == 0u) { xcd_barrier_complete(bar, b.x, nloc, nx); b.st[0] = nloc; b.st[1] = nx; }
        const unsigned old = xb_add(&bar[XB_XSUB(b.x)], 1u);
        const unsigned gen = old / nloc;
        if (old + 1u == (gen + 1u) * nloc) {
            __builtin_amdgcn_fence(__ATOMIC_RELEASE, "agent");
            asm volatile("s_waitcnt vmcnt(0)" ::: "memory");
            const unsigned og = xb_add(&bar[XB_TOP], 1u);
            const unsigned tg = og / nx;
            if (og + 1u == (tg + 1u) * nx) xb_add(&bar[XB_TOPGEN], 1u);
            else XB_SPIN(xb_ld(&bar[XB_TOPGEN]) == tg, bar);
            __builtin_amdgcn_fence(__ATOMIC_ACQUIRE, "agent");
            xb_add(&bar[XB_XGEN(b.x)], 1u);
            asm volatile("s_waitcnt vmcnt(0)" ::: "memory");
        } else {
            XB_SPIN(xb_ld(&bar[XB_XGEN(b.x)]) == gen, bar);
            __builtin_amdgcn_fence(__ATOMIC_ACQUIRE, "agent");
            asm volatile("s_waitcnt vmcnt(0)" ::: "memory");
        }
    }
    __syncthreads();
}

#ifndef REP0
#define REP0 1
#endif
#ifndef REP1
#define REP1 1
#endif
#ifndef REP2
#define REP2 1
#endif
#ifndef REP2A
#define REP2A 1
#endif
#ifndef REP2B
#define REP2B 1
#endif
#ifndef REP2C
#define REP2C 1
#endif
#ifndef REP2D
#define REP2D 1
#endif
#ifndef REP4A
#define REP4A 1
#endif
#ifndef REP3
#define REP3 1
#endif
#ifndef REP3B
#define REP3B 1
#endif
#ifndef REP4
#define REP4 1
#endif
constexpr int NWAVES = 8;
constexpr int DM = 2048, NPROJ = 7168, SEQ = 2048, NBATCH = 4, MP = NBATCH * SEQ  , MS = 32, MTOK = MP + MS  , MPAD = 8448, MMEM = 1024;
constexpr int WA = 768, WM = 512, NMEM = 256, PASTW = 2048;
constexpr float QSCALE = 0.12751743082459868f;
constexpr float DN_ALPHA = 1.189207115002721f;
constexpr float LN_EPS = 1e-5f, RMS_EPS = 1e-6f;
constexpr size_t OUT_Y = 0, OUT_YS = 16777216, OUT_KP = 16842752, OUT_VP = 23134208, OUT_SP = 29425664, OUT_MKP = 29818880, OUT_MVP = 30343168,
                 OUT_KS = 30867456, OUT_VS = 30892032, OUT_SS = 30916608, OUT_TOTAL = 34062336;
constexpr size_t MiB = 1u << 20;
constexpr size_t WS_CTL = 0, CTL_ZERO_BYTES = 1 * MiB;
constexpr size_t WS_LB = 1 * MiB;
constexpr size_t WS_COS = 2 * MiB, WS_SIN = 3 * MiB;
constexpr size_t WS_XB = 4 * MiB;
constexpr size_t WS_WT = 42 * MiB;
constexpr size_t WS_WOUTT = 74 * MiB;
constexpr size_t WS_QA = 82 * MiB, WS_KA = 95 * MiB, WS_VA = 108 * MiB, WS_GA = 121 * MiB;
constexpr size_t WS_QB = 134 * MiB, WS_KB = 147 * MiB, WS_VB = 160 * MiB, WS_GB = 173 * MiB;
constexpr size_t WS_LF = 186 * MiB;
constexpr size_t WS_QM = 211 * MiB, WS_GM = 220 * MiB;
constexpr size_t WS_MK = 229 * MiB, WS_MV = 230 * MiB;
constexpr size_t WS_Z = 231 * MiB;
constexpr size_t WS_OP = 264 * MiB;
constexpr size_t WS_LSE = 300 * MiB;
constexpr size_t WS_U = 301 * MiB, WS_SPV = 325 * MiB;
constexpr size_t WS_DC = 349 * MiB;
constexpr size_t WS_RS = 350 * MiB;
constexpr size_t WS_SAMP = 351 * MiB;
constexpr size_t WS_HO = 353 * MiB;
constexpr size_t WS_END = 384 * MiB;
constexpr int CW_BAR = 4096;
constexpr int RING_OFF = 0, RING_BYTES = 131072;
constexpr int LDSCTL_OFF = RING_BYTES, MISC_OFF = LDSCTL_OFF + 320;
constexpr int LDS_BYTES = 147456;

struct Args { const float* in[15]; float* out; unsigned char* ws; };

__device__ __forceinline__ float bf2f(unsigned h) { return __uint_as_float(h << 16); }
__device__ __forceinline__ float bflo(unsigned w) { return __uint_as_float(w << 16); }
__device__ __forceinline__ float bfhi(unsigned w) { return __uint_as_float(w & 0xffff0000u); }
__device__ __forceinline__ float wave_sum(float v) {
#pragma unroll
    for (int o = 1; o < 64; o <<= 1) v += __shfl_xor(v, o);
    return v;
}
__device__ __forceinline__ float sigmoidf_(float x) { return __builtin_amdgcn_rcpf(1.0f + __builtin_amdgcn_exp2f(-1.4426950408889634f * x)); }
__device__ __forceinline__ float siluf_(float x) { return x * sigmoidf_(x); }

namespace pg8 {
__host__ __device__ __forceinline__ int rowmap_win(int n) { if (n < 1536) { const int d = n & 127; return (n & ~127) + 8 * ((d & 63) >> 2) + 4 * (d >> 6) + (d & 3); } return n; }

struct EpiProj {
    static constexpr bool PERM = true, AFTER_DRAIN = false;
    unsigned char* ws; float* out;
    __device__ __forceinline__ void operator()(const f32x4 (&acc)[2][2][4][2], const Unit& u, int wr, int wc, int fr, int fq) const {
        const int pn = u.pn, pm = u.pm;
        int seg, colt;
        if (pn < 24) { seg = pn / 3; colt = (pn % 3) * 256; } else if (pn < 28) { seg = 8 + ((pn - 24) >> 1); colt = ((pn - 24) & 1) * 256; } else { seg = 10 + ((pn - 28) >> 1); colt = ((pn - 28) & 1) * 256; }
        const float* cosT = (const float*)(ws + WS_COS); const float* sinT = (const float*)(ws + WS_SIN); const float* LB = (const float*)(ws + WS_LB);
#pragma unroll
        for (int ai = 0; ai < 2; ++ai)
#pragma unroll
            for (int m = 0; m < 4; ++m) {
                const int row = pm * BM + ai * HALF + wr * 64 + m * 16 + fr;
#pragma unroll
                for (int bj = 0; bj < 2; ++bj) {
                    const int c0 = colt + bj * HALF + wc * 32 + 8 * fq;
                    f32x4 v0 = acc[ai][bj][m][0], v1 = acc[ai][bj][m][1];
                    if (seg >= 10) {
                        const int mr = row - MPAD;
                        float* o = out + (seg == 10 ? OUT_MKP : OUT_MVP) + (size_t)mr * WM + c0;
                        *(f32x4*)o = v0; *(f32x4*)(o + 4) = v1;
                        bf16_t* b = (bf16_t*)(ws + (seg == 10 ? WS_MK : WS_MV)) + (size_t)mr * WM + c0;
                        u32x4 w; w.x = cvt_pk_bf16(v0[0], v0[1]); w.y = cvt_pk_bf16(v0[2], v0[3]); w.z = cvt_pk_bf16(v1[0], v1[1]); w.w = cvt_pk_bf16(v1[2], v1[3]);
                        *(u32x4*)b = w;
                        continue;
                    }
                    if (seg <= 1) {
                        const int i0 = 4 * ((c0 & 127) >> 3);
                        const int pr = row < MP ? (row & (SEQ - 1)) : SEQ;
                        const f32x4 cs = *(const f32x4*)(cosT + pr * 64 + i0), sn = *(const f32x4*)(sinT + pr * 64 + i0);
                        const f32x4 o1 = v0 * cs - v1 * sn, o2 = v1 * cs + v0 * sn;
                        if (seg == 1) {
                            if (row < MTOK) {
                                float* o = (row < MP ? out + OUT_KP + (size_t)row * WA : out + OUT_KS + (size_t)(row - MP) * WA) + (c0 & ~127) + i0;
                                *(f32x4*)o = o1; *(f32x4*)(o + 64) = o2;
                            }
                            v0 = o1; v1 = o2;
                        } else { v0 = o1 * QSCALE; v1 = o2 * QSCALE; }
                    } else if (seg == 2) {
                        if (row < MTOK) {
                            float* o = (row < MP ? out + OUT_VP + (size_t)row * WA : out + OUT_VS + (size_t)(row - MP) * WA) + c0;
                            *(f32x4*)o = v0; *(f32x4*)(o + 4) = v1;
                        }
                    } else if (seg == 3 || seg == 7 || seg == 9) {
#pragma unroll
                        for (int e = 0; e < 4; ++e) { v0[e] = siluf_(v0[e]); v1[e] = siluf_(v1[e]); }
                    } else if (seg == 5) {
                        const f32x4 la = *(const f32x4*)(LB + c0), lb = *(const f32x4*)(LB + c0 + 4);
                        f32x4 l0, l1;
#pragma unroll
                        for (int e = 0; e < 4; ++e) {
                            const float sa = sigmoidf_(v0[e]), sb = sigmoidf_(v1[e]);
                            const float fa = la[e] + (1.0f - la[e]) * sa, fb = lb[e] + (1.0f - lb[e]) * sb;
                            l0[e] = __logf(fa); l1[e] = __logf(fb);
                            v0[e] = (1.0f - la[e]) * (1.0f - sa); v1[e] = (1.0f - lb[e]) * (1.0f - sb);
                        }
                        float* lf = (float*)(ws + WS_LF) + (size_t)row * WA + c0;
                        *(f32x4*)lf = l0; *(f32x4*)(lf + 4) = l1;
                    } else if (seg == 8) { v0 = v0 * QSCALE; v1 = v1 * QSCALE; }
                    size_t boff; int ld;
                    if (seg < 8) { boff = WS_QA + (size_t)seg * 13 * MiB; ld = WA; } else { boff = (seg == 8 ? WS_QM : WS_GM); ld = WM; }
                    bf16_t* b = (bf16_t*)(ws + boff) + (size_t)row * ld + c0;
                    u32x4 w; w.x = cvt_pk_bf16(v0[0], v0[1]); w.y = cvt_pk_bf16(v0[2], v0[3]); w.z = cvt_pk_bf16(v1[0], v1[1]); w.w = cvt_pk_bf16(v1[2], v1[3]);
                    *(u32x4*)b = w;
                }
            }
    }
};
static_assert(WS_KA == WS_QA + 13 * MiB && WS_VA == WS_QA + 26 * MiB && WS_GA == WS_QA + 39 * MiB && WS_QB == WS_QA + 52 * MiB && WS_KB == WS_QA + 65 * MiB && WS_VB == WS_QA + 78 * MiB && WS_GB == WS_QA + 91 * MiB, "segment buffers 13 MiB apart");

struct SchedProj {
    int G, c;
    __device__ __forceinline__ bool next(int i, Unit& u) const {
        const int L = i * G + c; constexpr int nM = 33, nN = 28, nwg = nM * nN;
        if (L >= nwg + 16) return false;
        if (L >= nwg) { const int j = L - nwg; u.pm = nM + (j >> 2); u.pn = nN + (j & 3); return true; }
        int wgid = L; { const int q = nwg / NXCD, r = nwg % NXCD, xcd = wgid % NXCD, off = wgid / NXCD; wgid = (xcd < r ? xcd * (q + 1) : r * (q + 1) + (xcd - r) * q) + off; }
        const int nig = WGM * nN, gid = wgid / nig, fm = gid * WGM, gsz = (nM - fm) < WGM ? (nM - fm) : WGM;
        u.pm = fm + ((wgid % nig) % gsz); u.pn = (wgid % nig) / gsz; return true;
    }
    __device__ __forceinline__ void a_ready(const Unit&) const {}
    __device__ __forceinline__ void done(const Unit&) const {}
};

struct EpiRes {
    static constexpr bool PERM = false, AFTER_DRAIN = false;
    const float* x; float* out;
    __device__ __forceinline__ void operator()(const f32x4 (&acc)[2][2][4][2], const Unit& u, int wr, int wc, int fr, int fq) const {
#pragma unroll
        for (int ai = 0; ai < 2; ++ai)
#pragma unroll
            for (int m = 0; m < 4; ++m) {
                const size_t ro = (size_t)(u.pm * BM + ai * HALF + wr * 64 + m * 16 + fr) * DM;
#pragma unroll
                for (int bj = 0; bj < 2; ++bj)
#pragma unroll
                    for (int n = 0; n < 2; ++n) {
                        const int col = u.pn * BM + bj * HALF + wc * 32 + n * 16 + 4 * fq;
                        const f32x4 xv = *(const f32x4*)(x + ro + col);
                        *(f32x4*)(out + ro + col) = acc[ai][bj][m][n] + xv * DN_ALPHA;
                    }
            }
    }
};
}

struct Frame {
    LAS unsigned char* lds;
    int tid, lane, wave, vcu, G, gw, NGW;
    unsigned char* ws; float* out;
    const float* in[15];
};

template <bool PERMROWS>
__device__ __forceinline__ void p0_transpose_item(const float* W, int K, int N, bf16* WT, int row_off, LAS float* scr, int item, int lane) {
    const int nblk = N / 32, kb = item / nblk, nb = item % nblk, k0 = 64 * kb, n0 = 32 * nb;
#pragma unroll 8
    for (int i = 0; i < 32; ++i) { const int kk = 2 * i + (lane >> 5); scr[kk * 33 + (lane & 31)] = W[(size_t)(k0 + kk) * N + n0 + (lane & 31)]; }
    LDS_WAIT(); asm volatile("" ::: "memory");
    const int c = lane & 7;
#pragma unroll
    for (int j = 0; j < 4; ++j) { const int n = (lane >> 3) + 8 * j; const LAS float* s = scr + (8 * c) * 33 + n;
        v4u o; o.x = pk2(s[0 * 33], s[1 * 33]); o.y = pk2(s[2 * 33], s[3 * 33]); o.z = pk2(s[4 * 33], s[5 * 33]); o.w = pk2(s[6 * 33], s[7 * 33]);
        const int drow = row_off + (PERMROWS ? pg8::rowmap_win(n0 + n) : n0 + n);
        *(GAS v4u*)(WT + (size_t)drow * K + k0 + 8 * c) = o; }
    LDS_WAIT(); asm volatile("" ::: "memory");
}
__device__ __forceinline__ void p0_prologue(Frame& F) {
    LAS float* scr = (LAS float*)(F.lds + RING_OFF + F.wave * 16384);
    const float* w_in = F.in[8]; const float* w_mem = F.in[9]; const float* w_out = F.in[12];
    bf16* WT = (bf16*)(F.ws + WS_WT); bf16* WOT = (bf16*)(F.ws + WS_WOUTT); bf16* XB = (bf16*)(F.ws + WS_XB);
    constexpr int I_IN = (DM / 64) * (NPROJ / 32), I_MEM = (DM / 64) * (1024 / 32), I_OUT = (DM / 64) * (DM / 32);
    for (int it = F.gw; it < I_IN + I_MEM + I_OUT; it += F.NGW) {
        int r = it;
        if (r < I_IN) { p0_transpose_item<true>(w_in, DM, NPROJ, WT, 0, scr, r, F.lane); continue; } r -= I_IN;
        if (r < I_MEM) { p0_transpose_item<false>(w_mem, DM, 1024, WT, NPROJ, scr, r, F.lane); continue; } r -= I_MEM;
        p0_transpose_item<false>(w_out, DM, DM, WOT, 0, scr, r, F.lane);
    }
    for (int m = F.gw; m < MPAD + MMEM; m += F.NGW) {
        GAS unsigned long long* o8 = (GAS unsigned long long*)(XB + (size_t)m * DM) + F.lane;
        if (m >= MTOK && m < MPAD) {
#pragma unroll
            for (int j = 0; j < 8; ++j) o8[64 * j] = 0ull;
            continue;
        }
        const float* src = m < MP ? F.in[0] + (size_t)m * DM : (m < MTOK ? F.in[1] + (size_t)(m - MP) * DM : F.in[7] + (size_t)(m - MPAD) * DM);
        const GAS f32x4* xr = (const GAS f32x4*)src + F.lane;
        f32x4 v[8];
#pragma unroll
        for (int j = 0; j < 8; ++j) v[j] = xr[64 * j];
#pragma unroll
        for (int j = 0; j < 8; ++j) o8[64 * j] = (unsigned long long)pk2(v[j].x, v[j].y) | ((unsigned long long)pk2(v[j].z, v[j].w) << 32);
    }
    {
        float* cosT = (float*)(F.ws + WS_COS); float* sinT = (float*)(F.ws + WS_SIN);
        const int gt = F.gw * 64 + F.lane, NT = F.NGW * 64;
        for (int e = gt; e < (SEQ + 1) * 64; e += NT) {
            const int pr = e >> 6, i = e & 63; const double pos = pr < SEQ ? (double)pr : 8192.0;
            double inv = 1.0; for (int k = 0; k < i; ++k) inv *= 0.8659643233600653;
            const double ang = pos * inv; const double kq = __builtin_floor(ang * 0.15915494309189535); const float red = (float)(ang - kq * 6.283185307179586);
            cosT[e] = cosf(red); sinT[e] = sinf(red);
        }
        float* LB = (float*)(F.ws + WS_LB); const float* raw = F.in[10];
        for (int e = gt; e < WA; e += NT) LB[e] = 1.0f / (1.0f + expf(raw[WA + e] - raw[e]));
    }
}

struct SM { float m, l, a0, a1; };
__device__ __forceinline__ void sm_step(SM& s, float sc, float v0, float v1) {
    const float mn = fmaxf(s.m, sc), f = __builtin_amdgcn_exp2f(s.m - mn), p = __builtin_amdgcn_exp2f(sc - mn);
    s.l = s.l * f + p; s.a0 = s.a0 * f + p * v0; s.a1 = s.a1 * f + p * v1; s.m = mn;
}
__device__ __forceinline__ void naive_attn_task(Frame& F, int task) {
    const int lane = F.lane; const bf16* QA = (const bf16*)(F.ws + WS_QA); const bf16* KA = (const bf16*)(F.ws + WS_KA); const bf16* VA = (const bf16*)(F.ws + WS_VA); const bf16* GA = (const bf16*)(F.ws + WS_GA);
    bf16* Z = (bf16*)(F.ws + WS_Z);
    const int r = task / 6, h = task % 6;
    SM s{-1e30f, 0.f, 0.f, 0.f};
    if (r < MP) {
        const int t = r & (SEQ - 1);
        const unsigned qq = *(const unsigned*)(QA + (size_t)r * WA + h * 128 + 2 * lane); const float q0 = bflo(qq), q1 = bfhi(qq);
        for (int br = 0; br < 3; ++br) {
            const int dil = br == 0 ? 1 : (br == 1 ? 4 : 16); int cnt = t / dil; cnt = (cnt < 128 ? cnt : 128) + 1;
            for (int j = 0; j < cnt; ++j) {
                const size_t ko = (size_t)(r - j * dil) * WA + h * 128 + 2 * lane;
                const unsigned kk = *(const unsigned*)(KA + ko), vv = *(const unsigned*)(VA + ko);
                const float sc = wave_sum(q0 * bflo(kk) + q1 * bfhi(kk));
                sm_step(s, sc, bflo(vv), bfhi(vv));
            }
        }
    } else {
        const int bs = r - MP; const int p = 8 * (((2 * lane) & 63) >> 2) + 4 * (lane >> 5) + ((2 * lane) & 3);
        const unsigned qq = *(const unsigned*)(QA + (size_t)r * WA + h * 128 + p); const float q0 = bflo(qq), q1 = bfhi(qq);
        const float* ck = F.in[2]; const float* cv = F.in[3];
        const float2 kn = *(const float2*)(F.out + OUT_KS + (size_t)bs * WA + h * 128 + 2 * lane), vn = *(const float2*)(F.out + OUT_VS + (size_t)bs * WA + h * 128 + 2 * lane);
        const float scn = wave_sum(q0 * kn.x + q1 * kn.y);
        for (int br = 0; br < 3; ++br) {
            const int dil = br == 0 ? 1 : (br == 1 ? 4 : 16);
            sm_step(s, scn, vn.x, vn.y);
            for (int j = 1; j <= 128; ++j) {
                const size_t ko = ((size_t)(bs * PASTW + PASTW - j * dil) * 6 + h) * 128 + 2 * lane;
                const float2 k2 = *(const float2*)(ck + ko), v2 = *(const float2*)(cv + ko);
                const float sc = wave_sum(q0 * k2.x + q1 * k2.y);
                sm_step(s, sc, v2.x, v2.y);
            }
        }
    }
    const float il = 1.0f / s.l; const unsigned gg = *(const unsigned*)(GA + (size_t)r * WA + h * 128 + 2 * lane);
    *(unsigned*)(Z + (size_t)r * DM + h * 128 + 2 * lane) = pk2(s.a0 * il * bflo(gg), s.a1 * il * bfhi(gg));
}
__device__ __forceinline__ void naive_mem_task(Frame& F, int task) {
    const int lane = F.lane; const bf16* QM = (const bf16*)(F.ws + WS_QM); const bf16* GM = (const bf16*)(F.ws + WS_GM); const bf16* MK = (const bf16*)(F.ws + WS_MK); const bf16* MV = (const bf16*)(F.ws + WS_MV);
    bf16* Z = (bf16*)(F.ws + WS_Z);
    const int r = task >> 2, h = task & 3;
    const unsigned qq = *(const unsigned*)(QM + (size_t)r * WM + h * 128 + 2 * lane); const float q0 = bflo(qq), q1 = bfhi(qq);
    SM s{-1e30f, 0.f, 0.f, 0.f};
    if (r < MP) {
        const int b = r >> 11;
        for (int m = 0; m < NMEM; ++m) {
            const size_t ko = (size_t)(b * NMEM + m) * WM + h * 128 + 2 * lane;
            const unsigned kk = *(const unsigned*)(MK + ko), vv = *(const unsigned*)(MV + ko);
            const float sc = wave_sum(q0 * bflo(kk) + q1 * bfhi(kk));
            sm_step(s, sc, bflo(vv), bfhi(vv));
        }
    } else {
        const int bs = r - MP; const float* ck = F.in[5]; const float* cv = F.in[6];
        for (int m = 0; m < NMEM; ++m) {
            const size_t ko = ((size_t)(bs * NMEM + m) * 4 + h) * 128 + 2 * lane;
            const float2 k2 = *(const float2*)(ck + ko), v2 = *(const float2*)(cv + ko);
            const float sc = wave_sum(q0 * k2.x + q1 * k2.y);
            sm_step(s, sc, v2.x, v2.y);
        }
    }
    const float il = 1.0f / s.l; const unsigned gg = *(const unsigned*)(GM + (size_t)r * WM + h * 128 + 2 * lane);
    *(unsigned*)(Z + (size_t)r * DM + 1536 + h * 128 + 2 * lane) = pk2(s.a0 * il * bflo(gg), s.a1 * il * bfhi(gg));
}
__device__ __forceinline__ void naive_hgrn_prompt_item(Frame& F, int item) {
    const int lane = F.lane; const int vb = item & 15, bh = item >> 4, h = bh % 6, b = bh / 6;
    const bf16* QB = (const bf16*)(F.ws + WS_QB); const bf16* KB = (const bf16*)(F.ws + WS_KB); const bf16* VB = (const bf16*)(F.ws + WS_VB); const float* LF = (const float*)(F.ws + WS_LF);
    float* HO = (float*)(F.ws + WS_HO);
    float S0[8], S1[8];
#pragma unroll
    for (int j = 0; j < 8; ++j) { S0[j] = 0.f; S1[j] = 0.f; }
    for (int t = 0; t < SEQ; ++t) {
        const size_t ro = (size_t)(b * SEQ + t) * WA + h * 128;
        const float qa = bf2f(QB[ro + lane]), qb = bf2f(QB[ro + lane + 64]), ka = bf2f(KB[ro + lane]), kb = bf2f(KB[ro + lane + 64]);
        const float fa = __expf(LF[ro + lane]), fb = __expf(LF[ro + lane + 64]);
        const v4u vv = *(const v4u*)(VB + ro + vb * 8);
        float v[8] = {bflo(vv.x), bfhi(vv.x), bflo(vv.y), bfhi(vv.y), bflo(vv.z), bfhi(vv.z), bflo(vv.w), bfhi(vv.w)};
        float o[8];
#pragma unroll
        for (int j = 0; j < 8; ++j) { S0[j] = fa * S0[j] + ka * v[j]; S1[j] = fb * S1[j] + kb * v[j]; o[j] = wave_sum(qa * S0[j] + qb * S1[j]); }
        if (lane == 0) { *(f32x4*)(HO + ro + vb * 8) = (f32x4){o[0], o[1], o[2], o[3]}; *(f32x4*)(HO + ro + vb * 8 + 4) = (f32x4){o[4], o[5], o[6], o[7]}; }
    }
    float* so = F.out + OUT_SP + ((size_t)bh * 128) * 128 + vb * 8;
    *(f32x4*)(so + (size_t)lane * 128) = (f32x4){S0[0], S0[1], S0[2], S0[3]}; *(f32x4*)(so + (size_t)lane * 128 + 4) = (f32x4){S0[4], S0[5], S0[6], S0[7]};
    *(f32x4*)(so + (size_t)(lane + 64) * 128) = (f32x4){S1[0], S1[1], S1[2], S1[3]}; *(f32x4*)(so + (size_t)(lane + 64) * 128 + 4) = (f32x4){S1[4], S1[5], S1[6], S1[7]};
}
__device__ __forceinline__ void hgrn_sample_item(Frame& F, int item) {
    const int lane = F.lane; const int kb = item & 7, bh = item >> 3, h = bh % 6, bs = bh / 6; const int r = MP + bs;
    const bf16* QB = (const bf16*)(F.ws + WS_QB); const bf16* KB = (const bf16*)(F.ws + WS_KB); const bf16* VB = (const bf16*)(F.ws + WS_VB); const float* LF = (const float*)(F.ws + WS_LF);
    const size_t ro = (size_t)r * WA + h * 128;
    const unsigned vv = *(const unsigned*)(VB + ro + 2 * lane); const float v0 = bflo(vv), v1 = bfhi(vv);
    const float* sp = F.in[4] + ((size_t)bh * 128 + kb * 16) * 128 + 2 * lane; float* sn = F.out + OUT_SS + ((size_t)bh * 128 + kb * 16) * 128 + 2 * lane;
    float o0 = 0.f, o1 = 0.f;
#pragma unroll 4
    for (int k = 0; k < 16; ++k) {
        const int kk = kb * 16 + k;
        const float q = bf2f(QB[ro + kk]), kf = bf2f(KB[ro + kk]), f = __expf(LF[ro + kk]);
        const float2 s = *(const float2*)(sp + (size_t)k * 128);
        const float n0 = f * s.x + kf * v0, n1 = f * s.y + kf * v1;
        *(float2*)(sn + (size_t)k * 128) = make_float2(n0, n1);
        o0 += q * n0; o1 += q * n1;
    }
    float* po = (float*)(F.ws + WS_SAMP) + ((size_t)bh * 8 + kb) * 128 + 2 * lane;
    *(float2*)po = make_float2(o0, o1);
}
__device__ __forceinline__ void hgrn_norm_task(Frame& F, int task) {
    const int lane = F.lane; const int r = task / 6, h = task % 6;
    const bf16* GB = (const bf16*)(F.ws + WS_GB); bf16* Z = (bf16*)(F.ws + WS_Z); const float* ng = F.in[11];
    float o0, o1;
    if (r < MP) { const float2 o = *(const float2*)((const float*)(F.ws + WS_HO) + (size_t)r * WA + h * 128 + 2 * lane); o0 = o.x; o1 = o.y; }
    else { const int bh = (r - MP) * 6 + h; o0 = 0.f; o1 = 0.f;
#pragma unroll
        for (int kb = 0; kb < 8; ++kb) { const float2 o = *(const float2*)((const float*)(F.ws + WS_SAMP) + ((size_t)bh * 8 + kb) * 128 + 2 * lane); o0 += o.x; o1 += o.y; } }
    const float ss = wave_sum(o0 * o0 + o1 * o1); const float rs = 1.0f / sqrtf(ss * (1.0f / 128.0f) + RMS_EPS);
    const unsigned gg = *(const unsigned*)(GB + (size_t)r * WA + h * 128 + 2 * lane); const float2 g2 = *(const float2*)(ng + h * 128 + 2 * lane);
    *(unsigned*)(Z + (size_t)r * DM + WA + h * 128 + 2 * lane) = pk2(o0 * rs * g2.x * bflo(gg), o1 * rs * g2.y * bfhi(gg));
}

__device__ __forceinline__ void sample_outproj(Frame& F) {
    const bf16* Z = (const bf16*)(F.ws + WS_Z); const bf16* WOT = (const bf16*)(F.ws + WS_WOUTT); float* RS = (float*)(F.ws + WS_RS);
    LAS float* red = (LAS float*)(F.lds + RING_OFF);
    const int w = F.wave, lane = F.lane, fr = lane & 15, fq = lane >> 4;
    for (int cb = F.vcu; cb < DM / 8; cb += F.G) {
        const bf16* z0 = Z + (size_t)(MP + fr) * DM + 256 * w + 8 * fq; const bf16* z1 = z0 + (size_t)16 * DM;
        const bf16* wp = WOT + (size_t)(8 * cb + (fr & 7)) * DM + 256 * w + 8 * fq;
        bf16x8 a0[8], a1[8], bb[8];
#pragma unroll
        for (int ks = 0; ks < 8; ++ks) { a0[ks] = *(const bf16x8*)(z0 + 32 * ks); a1[ks] = *(const bf16x8*)(z1 + 32 * ks); bb[ks] = *(const bf16x8*)(wp + 32 * ks); }
        f32x4 c0 = (f32x4){0.f, 0.f, 0.f, 0.f}, c1 = (f32x4){0.f, 0.f, 0.f, 0.f};
#pragma unroll
        for (int ks = 0; ks < 8; ++ks) { c0 = __builtin_amdgcn_mfma_f32_16x16x32_bf16(a0[ks], bb[ks], c0, 0, 0, 0); c1 = __builtin_amdgcn_mfma_f32_16x16x32_bf16(a1[ks], bb[ks], c1, 0, 0, 0); }
        *(LAS f32x4*)(red + ((w * 2 + 0) * 64 + lane) * 4) = c0; *(LAS f32x4*)(red + ((w * 2 + 1) * 64 + lane) * 4) = c1;
        LDS_WAIT(); __syncthreads();
        if (F.tid < 256) {
            const int row = F.tid >> 3, col = F.tid & 7, rt = row >> 4, rr = row & 15, ln = (rr >> 2) * 16 + col, reg = rr & 3;
            float s = 0.f;
#pragma unroll
            for (int ww = 0; ww < 8; ++ww) s += red[((ww * 2 + rt) * 64 + ln) * 4 + reg];
            RS[(size_t)row * DM + 8 * cb + col] = s + DN_ALPHA * F.in[1][(size_t)row * DM + 8 * cb + col];
        }
        LDS_WAIT(); __syncthreads();
    }
}
__device__ __forceinline__ void ln_row(Frame& F, const float* rrow, float* orow) {
    const GAS f32x4* xr = (const GAS f32x4*)rrow + F.lane; const GAS f32x4* gp = (const GAS f32x4*)F.in[13] + F.lane; const GAS f32x4* bp = (const GAS f32x4*)F.in[14] + F.lane;
    f32x4 v[8]; float s = 0.f;
#pragma unroll
    for (int j = 0; j < 8; ++j) { v[j] = xr[64 * j]; s += (v[j].x + v[j].y) + (v[j].z + v[j].w); }
    const float mean = wave_sum(s) * (1.f / DM); float s2 = 0.f;
#pragma unroll
    for (int j = 0; j < 8; ++j) { v[j] = v[j] - mean; s2 += (v[j].x * v[j].x + v[j].y * v[j].y) + (v[j].z * v[j].z + v[j].w * v[j].w); }
    const float rstd = 1.f / sqrtf(wave_sum(s2) * (1.f / DM) + LN_EPS);
    GAS f32x4* op = (GAS f32x4*)orow + F.lane;
#pragma unroll
    for (int j = 0; j < 8; ++j) op[64 * j] = v[j] * rstd * gp[64 * j] + bp[64 * j];
}


typedef short v4i16_t __attribute__((ext_vector_type(4)));
typedef unsigned u32x2 __attribute__((ext_vector_type(2)));
typedef unsigned u32x4 __attribute__((ext_vector_type(4)));
__device__ __forceinline__ unsigned cvtpk(float lo, float hi) { return pg8::cvt_pk_bf16(lo, hi); }
__device__ __forceinline__ v4i16_t tr_read(LAS unsigned char* p) { return __builtin_amdgcn_ds_read_tr16_b64_v4i16((LAS v4i16_t*)p); }
constexpr float NEGBIG = -1e30f;
constexpr int ATT_K_OFF = 0, ATT_V_OFF = 65536;
template <bool BAND>
__device__ __forceinline__ void attn_unit(Frame& F, const bf16* kbase, const bf16* vbase, long kstride, int skip, const bf16* qbase, long qstride,
                                          bf16* obase, long ostride, float* lse, int lse_stride, const bf16* gate, long gstride) {
    constexpr int NT = BAND ? 9 : 16;
    LAS unsigned char* lds = F.lds + RING_OFF;
    const int w = F.wave, lane = F.lane, fr = lane & 15, fq = lane >> 4;
    if (skip) {
        for (int u = F.tid; u < skip * 16; u += NWAVES * 64) { *(LAS v4u*)(lds + ATT_K_OFF + u * 16) = (v4u){0u, 0u, 0u, 0u}; *(LAS v4u*)(lds + ATT_V_OFF + u * 16) = (v4u){0u, 0u, 0u, 0u}; }
    }
#pragma unroll
    for (int i = 0; i < 8; ++i) {
        const int R0 = 32 * i + 4 * w;
        if (R0 >= skip) {
            const int row = R0 + (lane >> 4), chp = lane & 15;
            const int ck = chp ^ (row & 15), cv = chp ^ (((row & 3) << 2) | (((row >> 2) & 1) << 1));
            __builtin_amdgcn_global_load_lds((const unsigned*)(kbase + (long)row * kstride + ck * 8), (LAS unsigned*)(lds + ATT_K_OFF + R0 * 256), 16, 0, 0);
            __builtin_amdgcn_global_load_lds((const unsigned*)(vbase + (long)row * kstride + cv * 8), (LAS unsigned*)(lds + ATT_V_OFF + R0 * 256), 16, 0, 0);
        }
    }
    bf16x8 qf[4];
    { const bf16* qr = qbase + (long)(16 * w + fr) * qstride + 8 * fq;
#pragma unroll
      for (int ks = 0; ks < 4; ++ks) qf[ks] = *(const bf16x8*)(qr + 32 * ks); }
    asm volatile("s_waitcnt vmcnt(0) lgkmcnt(0)" ::: "memory");
    __syncthreads();
    const int kt0 = BAND ? w : 0;
    f32x4 s[NT];
#pragma unroll
    for (int j = 0; j < NT; ++j) {
        s[j] = (f32x4){0.f, 0.f, 0.f, 0.f};
        LAS unsigned char* kp = lds + ATT_K_OFF + (16 * (kt0 + j) + fr) * 256;
#pragma unroll
        for (int ks = 0; ks < 4; ++ks) {
            const bf16x8 kf = *(const LAS bf16x8*)(kp + 16 * ((4 * ks + fq) ^ fr));
            s[j] = __builtin_amdgcn_mfma_f32_16x16x32_bf16(kf, qf[ks], s[j], 0, 0, 0);
        }
    }
    if (BAND) {
#pragma unroll
        for (int reg = 0; reg < 4; ++reg) { const int kap = 4 * fq + reg; if (kap < fr) s[0][reg] = NEGBIG; if (kap > fr) s[NT - 1][reg] = NEGBIG; }
        if (skip) {
#pragma unroll
            for (int j = 0; j < 8; ++j) if (kt0 + j < 8) s[j] = (f32x4){NEGBIG, NEGBIG, NEGBIG, NEGBIG};
        }
    }
    float mx = NEGBIG;
#pragma unroll
    for (int j = 0; j < NT; ++j) mx = fmaxf(fmaxf(mx, fmaxf(s[j][0], s[j][1])), fmaxf(s[j][2], s[j][3]));
    mx = fmaxf(mx, __shfl_xor(mx, 16)); mx = fmaxf(mx, __shfl_xor(mx, 32));
    float lsum = 0.f;
#pragma unroll
    for (int j = 0; j < NT; ++j)
#pragma unroll
        for (int reg = 0; reg < 4; ++reg) { const float p = __builtin_amdgcn_exp2f(s[j][reg] - mx); s[j][reg] = p; lsum += p; }
    lsum += __shfl_xor(lsum, 16); lsum += __shfl_xor(lsum, 32);
    f32x4 o[8];
#pragma unroll
    for (int dg = 0; dg < 8; ++dg) o[dg] = (f32x4){0.f, 0.f, 0.f, 0.f};
    const int qq = fr >> 2, pp = fr & 3, sg = (qq << 2) | ((fq & 1) << 1);
#pragma unroll
    for (int i = 0; i < (NT + 1) / 2; ++i) {
        u32x4 pb; pb.x = cvtpk(s[2 * i][0], s[2 * i][1]); pb.y = cvtpk(s[2 * i][2], s[2 * i][3]);
        if (2 * i + 1 < NT) { pb.z = cvtpk(s[2 * i + 1 < NT ? 2 * i + 1 : 0][0], s[2 * i + 1 < NT ? 2 * i + 1 : 0][1]); pb.w = cvtpk(s[2 * i + 1 < NT ? 2 * i + 1 : 0][2], s[2 * i + 1 < NT ? 2 * i + 1 : 0][3]); } else { pb.z = 0u; pb.w = 0u; }
        LAS unsigned char* vrow = lds + ATT_V_OFF + (16 * (kt0 + 2 * i) + 4 * fq + qq) * 256 + 8 * (pp & 1);
#pragma unroll
        for (int dg = 0; dg < 8; ++dg) {
            LAS unsigned char* va = vrow + 16 * ((2 * dg + (pp >> 1)) ^ sg);
            const v4i16_t lo = tr_read(va);
            v4i16_t hi = (v4i16_t){0, 0, 0, 0};
            if (2 * i + 1 < NT) hi = tr_read(va + 4096);
            const bf16x8 af = (bf16x8){lo[0], lo[1], lo[2], lo[3], hi[0], hi[1], hi[2], hi[3]};
            o[dg] = __builtin_amdgcn_mfma_f32_16x16x32_bf16(af, __builtin_bit_cast(bf16x8, pb), o[dg], 0, 0, 0);
        }
    }
    const float il = 1.0f / lsum; const int qi = 16 * w + fr;
    bf16* op = obase + (long)qi * ostride + 4 * fq;
    if (BAND) {
#pragma unroll
        for (int dg = 0; dg < 8; ++dg) { u32x2 w2; w2.x = cvtpk(o[dg][0] * il, o[dg][1] * il); w2.y = cvtpk(o[dg][2] * il, o[dg][3] * il); *(u32x2*)(op + 16 * dg) = w2; }
        if (fq == 0) lse[(long)qi * lse_stride] = mx + __log2f(lsum);
    } else {
        const bf16* gp = gate + (long)qi * gstride + 4 * fq;
#pragma unroll
        for (int dg = 0; dg < 8; ++dg) { const u32x2 g2 = *(const u32x2*)(gp + 16 * dg);
            u32x2 w2; w2.x = cvtpk(o[dg][0] * il * bflo(g2.x), o[dg][1] * il * bfhi(g2.x)); w2.y = cvtpk(o[dg][2] * il * bflo(g2.y), o[dg][3] * il * bfhi(g2.y)); *(u32x2*)(op + 16 * dg) = w2; }
    }
    __syncthreads();
}
__device__ __forceinline__ void attn_unit_dispatch(Frame& F, int u) {
    if (u < 256) {
        const int qb = u & 15, bh = u >> 4, h = bh & 3, b = bh >> 2;
        const bf16* MK = (const bf16*)(F.ws + WS_MK) + (size_t)(b * NMEM) * WM + h * 128; const bf16* MV = (const bf16*)(F.ws + WS_MV) + (size_t)(b * NMEM) * WM + h * 128;
        const size_t r0 = (size_t)b * SEQ + qb * 128;
        attn_unit<false>(F, MK, MV, WM, 0, (const bf16*)(F.ws + WS_QM) + r0 * WM + h * 128, WM, (bf16*)(F.ws + WS_Z) + r0 * DM + 1536 + h * 128, DM, nullptr, 0, (const bf16*)(F.ws + WS_GM) + r0 * WM + h * 128, WM);
    } else {
        const int v = u - 256, br = v / 384, rem = v % 384, cb = rem & 15, bh = rem >> 4, h = bh % 6, b = bh / 6;
        const int dil = br == 0 ? 1 : (br == 1 ? 4 : 16), nb = 16 / dil, cls = cb / nb, n = cb % nb;
        const long tok0 = (long)(128 * (n - 1)) * dil + cls;
        const bf16* kb = (const bf16*)(F.ws + WS_KA) + ((long)b * SEQ + tok0) * WA + h * 128; const bf16* vb = (const bf16*)(F.ws + WS_VA) + ((long)b * SEQ + tok0) * WA + h * 128;
        const long q0 = (long)b * SEQ + (long)(128 * n) * dil + cls;
        attn_unit<true>(F, kb, vb, (long)dil * WA, n == 0 ? 128 : 0, (const bf16*)(F.ws + WS_QA) + q0 * WA + h * 128, (long)dil * WA,
                        (bf16*)(F.ws + WS_OP) + ((size_t)br * MP + q0) * WA + h * 128, (long)dil * WA, (float*)(F.ws + WS_LSE) + ((size_t)br * MP + q0) * 6 + h, dil * 6, nullptr, 0);
    }
}

constexpr int H_TOT = 0, H_SSQ = 2048, H_A = 4096, H_B = H_A + 16384, H_C = H_B + 16384, H_V = H_C + 16384;
constexpr float LOG2E = 1.4426950408889634f;
__device__ __forceinline__ int sig_tr(int row) { return ((row & 3) << 2) | (((row >> 2) & 1) << 1); }
__device__ __forceinline__ void hgrn_stage_v(Frame& F, LAS unsigned char* lds, const bf16* vsrc  ) {
#pragma unroll
    for (int i = 0; i < 2; ++i) {
        const int R0 = 8 * F.wave + 4 * i, row = R0 + (F.lane >> 4), chp = F.lane & 15, cv = chp ^ sig_tr(row);
        __builtin_amdgcn_global_load_lds((const unsigned*)(vsrc + (long)row * WA + cv * 8), (LAS unsigned*)(lds + H_V + R0 * 256), 16, 0, 0);
    }
}
__device__ __forceinline__ bf16x8 tr_pair(LAS unsigned char* a) { const v4i16_t lo = tr_read(a), hi = tr_read(a + 4096); return (bf16x8){lo[0], lo[1], lo[2], lo[3], hi[0], hi[1], hi[2], hi[3]}; }
__device__ __forceinline__ void hgrn_stage1_unit(Frame& F, int unit) {
    LAS unsigned char* lds = F.lds + RING_OFF;
    const int tid = F.tid, lane = F.lane, w = F.wave, fr = lane & 15, fq = lane >> 4;
    const int c = unit & 31, bh = unit >> 5, h = bh % 6, b = bh / 6;
    const size_t row0 = (size_t)b * SEQ + 64 * c;
    const int k = tid & 127, p = tid >> 7;
    hgrn_stage_v(F, lds, (const bf16*)(F.ws + WS_VB) + row0 * WA + h * 128);
    const float* lf = (const float*)(F.ws + WS_LF) + (row0 + 16 * p) * WA + h * 128 + k;
    const bf16* kkp = (const bf16*)(F.ws + WS_KB) + (row0 + 16 * p) * WA + h * 128 + k;
    float cs[16]; unsigned short kk[16];
#pragma unroll
    for (int i = 0; i < 16; ++i) { cs[i] = lf[(size_t)i * WA]; kk[i] = kkp[(size_t)i * WA]; }
#pragma unroll
    for (int i = 1; i < 16; ++i) cs[i] += cs[i - 1];
    LAS float* tot = (LAS float*)(lds + H_TOT);
    tot[p * 128 + k] = cs[15];
    LDS_WAIT(); __syncthreads();
    const float t0 = tot[k], t1 = tot[128 + k], t2 = tot[256 + k], t3 = tot[384 + k];
    const float off = (p > 0 ? t0 : 0.f) + (p > 1 ? t1 : 0.f) + (p > 2 ? t2 : 0.f), blast = (t0 + t1) + (t2 + t3);
#pragma unroll
    for (int i = 0; i < 16; ++i) {
        const int s = 16 * p + i; const float kh = bf2f(kk[i]) * __builtin_amdgcn_exp2f((blast - (cs[i] + off)) * LOG2E);
        *(LAS unsigned short*)(lds + H_A + s * 256 + 16 * ((k >> 3) ^ sig_tr(s)) + 2 * (k & 7)) = (unsigned short)f2bf(kh);
    }
    if (p == 0) ((float*)(F.ws + WS_DC))[(size_t)unit * 128 + k] = __builtin_amdgcn_exp2f(blast * LOG2E);
    asm volatile("s_waitcnt vmcnt(0) lgkmcnt(0)" ::: "memory");
    __syncthreads();
    const int vt = w, qq = fr >> 2, pp = fr & 3, sg = (qq << 2) | ((fq & 1) << 1);
    bf16x8 vf[2];
#pragma unroll
    for (int ss = 0; ss < 2; ++ss) vf[ss] = tr_pair(lds + H_V + (32 * ss + 4 * fq + qq) * 256 + 16 * ((2 * vt + (pp >> 1)) ^ sg) + 8 * (pp & 1));
    f32x4 acc[8];
#pragma unroll
    for (int kt = 0; kt < 8; ++kt) {
        acc[kt] = (f32x4){0.f, 0.f, 0.f, 0.f};
#pragma unroll
        for (int ss = 0; ss < 2; ++ss) {
            const bf16x8 af = tr_pair(lds + H_A + (32 * ss + 4 * fq + qq) * 256 + 16 * ((2 * kt + (pp >> 1)) ^ sg) + 8 * (pp & 1));
            acc[kt] = __builtin_amdgcn_mfma_f32_16x16x32_bf16(af, vf[ss], acc[kt], 0, 0, 0);
        }
    }
    bf16* U = (bf16*)(F.ws + WS_U) + ((size_t)unit * 32 + vt * 4) * 512 + lane * 8;
#pragma unroll
    for (int ks = 0; ks < 4; ++ks) {
        u32x4 wv; wv.x = cvtpk(acc[2 * ks][0], acc[2 * ks][1]); wv.y = cvtpk(acc[2 * ks][2], acc[2 * ks][3]); wv.z = cvtpk(acc[2 * ks + 1][0], acc[2 * ks + 1][1]); wv.w = cvtpk(acc[2 * ks + 1][2], acc[2 * ks + 1][3]);
        *(u32x4*)(U + ks * 512) = wv;
    }
    __syncthreads();
}
__device__ __forceinline__ void hgrn_scan_task(Frame& F, int task) {
    const int lane = F.lane, fr = lane & 15, fq = lane >> 4; const int f = task & 31, bh = task >> 5, vt = f >> 2, ks = f & 3;
    const bf16* U = (const bf16*)(F.ws + WS_U) + ((size_t)(bh * 32) * 32 + f) * 512 + lane * 8; bf16* SP = (bf16*)(F.ws + WS_SPV) + ((size_t)(bh * 32) * 32 + f) * 512 + lane * 8;
    const float* DC = (const float*)(F.ws + WS_DC) + (size_t)(bh * 32) * 128 + 32 * ks + 4 * fq;
    float S[8];
#pragma unroll
    for (int j = 0; j < 8; ++j) S[j] = 0.f;
    for (int c0 = 0; c0 < 32; c0 += 4) {
        u32x4 u[4]; f32x4 d0[4], d1[4];
#pragma unroll
        for (int i = 0; i < 4; ++i) { u[i] = *(const u32x4*)(U + (size_t)(c0 + i) * 32 * 512); d0[i] = *(const f32x4*)(DC + (c0 + i) * 128); d1[i] = *(const f32x4*)(DC + (c0 + i) * 128 + 16); }
#pragma unroll
        for (int i = 0; i < 4; ++i) {
            u32x4 sv; sv.x = cvtpk(S[0], S[1]); sv.y = cvtpk(S[2], S[3]); sv.z = cvtpk(S[4], S[5]); sv.w = cvtpk(S[6], S[7]);
            *(u32x4*)(SP + (size_t)(c0 + i) * 32 * 512) = sv;
            S[0] = d0[i][0] * S[0] + bflo(u[i].x); S[1] = d0[i][1] * S[1] + bfhi(u[i].x); S[2] = d0[i][2] * S[2] + bflo(u[i].y); S[3] = d0[i][3] * S[3] + bfhi(u[i].y);
            S[4] = d1[i][0] * S[4] + bflo(u[i].z); S[5] = d1[i][1] * S[5] + bfhi(u[i].z); S[6] = d1[i][2] * S[6] + bflo(u[i].w); S[7] = d1[i][3] * S[7] + bfhi(u[i].w);
        }
    }
    float* so = F.out + OUT_SP + ((size_t)bh * 128 + 32 * ks + 4 * fq) * 128 + 16 * vt + fr;
#pragma unroll
    for (int j = 0; j < 4; ++j) { so[(size_t)j * 128] = S[j]; so[(size_t)(16 + j) * 128] = S[4 + j]; }
}
__device__ __forceinline__ void hgrn_stage3_unit(Frame& F, int unit) {
    LAS unsigned char* lds = F.lds + RING_OFF;
    const int tid = F.tid, lane = F.lane, w = F.wave, fr = lane & 15, fq = lane >> 4;
    const int c = unit & 31, bh = unit >> 5, h = bh % 6, b = bh / 6;
    const size_t row0 = (size_t)b * SEQ + 64 * c;
    const int k = tid & 127, p = tid >> 7;
    hgrn_stage_v(F, lds, (const bf16*)(F.ws + WS_VB) + row0 * WA + h * 128);
    const float* lf = (const float*)(F.ws + WS_LF) + (row0 + 16 * p) * WA + h * 128 + k;
    const bf16* kkp = (const bf16*)(F.ws + WS_KB) + (row0 + 16 * p) * WA + h * 128 + k; const bf16* qp = (const bf16*)(F.ws + WS_QB) + (row0 + 16 * p) * WA + h * 128 + k;
    float cs[16]; unsigned short kk[16], qv[16];
#pragma unroll
    for (int i = 0; i < 16; ++i) { cs[i] = lf[(size_t)i * WA]; kk[i] = kkp[(size_t)i * WA]; qv[i] = qp[(size_t)i * WA]; }
#pragma unroll
    for (int i = 1; i < 16; ++i) cs[i] += cs[i - 1];
    LAS float* tot = (LAS float*)(lds + H_TOT);
    tot[p * 128 + k] = cs[15];
    LDS_WAIT(); __syncthreads();
    const float t0 = tot[k], t1 = tot[128 + k], t2 = tot[256 + k];
    const float off = (p > 0 ? t0 : 0.f) + (p > 1 ? t1 : 0.f) + (p > 2 ? t2 : 0.f), bref = t0 + t1;
#pragma unroll
    for (int i = 0; i < 16; ++i) {
        const int s = 16 * p + i; const float bs = cs[i] + off, qf = bf2f(qv[i]);
        const float e1 = fminf(fmaxf((bs - bref) * LOG2E, -100.f), 100.f);
        const float qt = qf * __builtin_amdgcn_exp2f(e1), kt = bf2f(kk[i]) * __builtin_amdgcn_exp2f(-e1), qh = qf * __builtin_amdgcn_exp2f(bs * LOG2E);
        const int o = s * 256 + 16 * ((k >> 3) ^ (s & 15)) + 2 * (k & 7);
        *(LAS unsigned short*)(lds + H_A + o) = (unsigned short)f2bf(qt);
        *(LAS unsigned short*)(lds + H_B + o) = (unsigned short)f2bf(kt);
        *(LAS unsigned short*)(lds + H_C + o) = (unsigned short)f2bf(qh);
    }
    asm volatile("s_waitcnt vmcnt(0) lgkmcnt(0)" ::: "memory");
    __syncthreads();
    const int tt = w & 3, vh = w >> 2, qq = fr >> 2, pp = fr & 3, sg = (qq << 2) | ((fq & 1) << 1);
    bf16x8 qtf[4];
#pragma unroll
    for (int ks = 0; ks < 4; ++ks) qtf[ks] = *(const LAS bf16x8*)(lds + H_A + (16 * tt + fr) * 256 + 16 * ((4 * ks + fq) ^ fr));
    f32x4 at[4];
#pragma unroll
    for (int si = 0; si < 4; ++si) {
        at[si] = (f32x4){0.f, 0.f, 0.f, 0.f};
        if (si <= tt) {
#pragma unroll
            for (int ks = 0; ks < 4; ++ks) {
                const bf16x8 kf = *(const LAS bf16x8*)(lds + H_B + (16 * si + fr) * 256 + 16 * ((4 * ks + fq) ^ fr));
                at[si] = __builtin_amdgcn_mfma_f32_16x16x32_bf16(kf, qtf[ks], at[si], 0, 0, 0);
            }
            if (si == tt) {
#pragma unroll
                for (int reg = 0; reg < 4; ++reg) if (4 * fq + reg > fr) at[si][reg] = 0.f;
            }
        }
    }
    f32x4 o[4];
#pragma unroll
    for (int i = 0; i < 4; ++i) o[i] = (f32x4){0.f, 0.f, 0.f, 0.f};
#pragma unroll
    for (int sp = 0; sp < 2; ++sp) {
        if (2 * sp <= tt) {
            u32x4 pb; pb.x = cvtpk(at[2 * sp][0], at[2 * sp][1]); pb.y = cvtpk(at[2 * sp][2], at[2 * sp][3]); pb.z = cvtpk(at[2 * sp + 1][0], at[2 * sp + 1][1]); pb.w = cvtpk(at[2 * sp + 1][2], at[2 * sp + 1][3]);
#pragma unroll
            for (int i = 0; i < 4; ++i) {
                const bf16x8 vf = tr_pair(lds + H_V + (32 * sp + 4 * fq + qq) * 256 + 16 * ((2 * (4 * vh + i) + (pp >> 1)) ^ sg) + 8 * (pp & 1));
                o[i] = __builtin_amdgcn_mfma_f32_16x16x32_bf16(vf, __builtin_bit_cast(bf16x8, pb), o[i], 0, 0, 0);
            }
        }
    }
    const bf16* SP = (const bf16*)(F.ws + WS_SPV) + ((size_t)unit * 32) * 512 + lane * 8;
#pragma unroll
    for (int ks = 0; ks < 4; ++ks) {
        const int trow = 16 * tt + fr;
        const u32x2 qa = *(const LAS u32x2*)(lds + H_C + trow * 256 + 16 * ((4 * ks + (fq >> 1)) ^ fr) + 8 * (fq & 1));
        const u32x2 qb = *(const LAS u32x2*)(lds + H_C + trow * 256 + 16 * ((4 * ks + 2 + (fq >> 1)) ^ fr) + 8 * (fq & 1));
        const u32x4 qh = (u32x4){qa.x, qa.y, qb.x, qb.y};
#pragma unroll
        for (int i = 0; i < 4; ++i) {
            const bf16x8 sf = *(const bf16x8*)(SP + (size_t)((4 * vh + i) * 4 + ks) * 512);
            o[i] = __builtin_amdgcn_mfma_f32_16x16x32_bf16(sf, __builtin_bit_cast(bf16x8, qh), o[i], 0, 0, 0);
        }
    }
    float ss = 0.f;
#pragma unroll
    for (int i = 0; i < 4; ++i) ss += (o[i][0] * o[i][0] + o[i][1] * o[i][1]) + (o[i][2] * o[i][2] + o[i][3] * o[i][3]);
    ss += __shfl_xor(ss, 16); ss += __shfl_xor(ss, 32);
    LAS float* ssq = (LAS float*)(lds + H_SSQ);
    if (fq == 0) ssq[vh * 64 + 16 * tt + fr] = ss;
    LDS_WAIT(); __syncthreads();
    const float tot2 = ssq[16 * tt + fr] + ssq[64 + 16 * tt + fr];
    const float rs = 1.0f / sqrtf(tot2 * (1.0f / 128.0f) + RMS_EPS);
    const size_t row = row0 + 16 * tt + fr;
    const bf16* gb = (const bf16*)(F.ws + WS_GB) + row * WA + h * 128 + 64 * vh + 4 * fq; const float* ng = F.in[11] + h * 128 + 64 * vh + 4 * fq;
    bf16* zp = (bf16*)(F.ws + WS_Z) + row * DM + WA + h * 128 + 64 * vh + 4 * fq;
#pragma unroll
    for (int i = 0; i < 4; ++i) {
        const u32x2 g2 = *(const u32x2*)(gb + 16 * i); const f32x4 n4 = *(const f32x4*)(ng + 16 * i);
        u32x2 w2; w2.x = cvtpk(o[i][0] * rs * n4[0] * bflo(g2.x), o[i][1] * rs * n4[1] * bfhi(g2.x)); w2.y = cvtpk(o[i][2] * rs * n4[2] * bflo(g2.y), o[i][3] * rs * n4[3] * bfhi(g2.y));
        *(u32x2*)(zp + 16 * i) = w2;
    }
    __syncthreads();
}
constexpr int PSTR = 132;
constexpr size_t SAMP_HG = 0, SAMP_AT = 1 * MiB, SAMP_ME = 1 * MiB + 768 * 1024;
__device__ __forceinline__ f32x4 load_q_true(const bf16* qhead, int li) { const u32x2 w = *(const u32x2*)(qhead + 8 * (li & 15) + 4 * (li >> 4)); return (f32x4){bflo(w.x), bfhi(w.x), bflo(w.y), bfhi(w.y)}; }
__device__ __forceinline__ f32x4 load_q_nat(const bf16* qhead, int li) { const u32x2 w = *(const u32x2*)(qhead + 4 * li); return (f32x4){bflo(w.x), bfhi(w.x), bflo(w.y), bfhi(w.y)}; }
__device__ __forceinline__ void decode_seq(const f32x4 q4, const float* kb, const float* vb, long stride, int nsteps, int lane, float* rec) {
    const int hl = lane >> 5, li = lane & 31;
    const float* kp = kb + hl * stride + 4 * li; const float* vp = vb + hl * stride + 4 * li;
    float m = NEGBIG, l = 0.f; f32x4 a = (f32x4){0.f, 0.f, 0.f, 0.f};
    f32x4 k[4], v[4], kn[4], vn[4];
#pragma unroll
    for (int u = 0; u < 4; ++u) { k[u] = *(const f32x4*)(kp + (long)(2 * u) * stride); v[u] = *(const f32x4*)(vp + (long)(2 * u) * stride); }
    for (int i = 0; i < nsteps; i += 4) {
        const int inext = (i + 4 < nsteps) ? i + 4 : i;
#pragma unroll
        for (int u = 0; u < 4; ++u) { kn[u] = *(const f32x4*)(kp + (long)(2 * (inext + u)) * stride); vn[u] = *(const f32x4*)(vp + (long)(2 * (inext + u)) * stride); }
        float sc[4];
#pragma unroll
        for (int u = 0; u < 4; ++u) sc[u] = (q4[0] * k[u][0] + q4[1] * k[u][1]) + (q4[2] * k[u][2] + q4[3] * k[u][3]);
#pragma unroll
        for (int o = 1; o < 32; o <<= 1)
#pragma unroll
            for (int u = 0; u < 4; ++u) sc[u] += __shfl_xor(sc[u], o);
#pragma unroll
        for (int u = 0; u < 4; ++u) { const float mn = fmaxf(m, sc[u]), f = __builtin_amdgcn_exp2f(m - mn), p = __builtin_amdgcn_exp2f(sc[u] - mn); l = l * f + p; a = a * f + v[u] * p; m = mn; }
#pragma unroll
        for (int u = 0; u < 4; ++u) { k[u] = kn[u]; v[u] = vn[u]; }
    }
    const float m2 = __shfl_xor(m, 32), l2 = __shfl_xor(l, 32);
    f32x4 a2; a2[0] = __shfl_xor(a[0], 32); a2[1] = __shfl_xor(a[1], 32); a2[2] = __shfl_xor(a[2], 32); a2[3] = __shfl_xor(a[3], 32);
    const float M = fmaxf(m, m2), f1 = __builtin_amdgcn_exp2f(m - M), f2 = __builtin_amdgcn_exp2f(m2 - M);
    if (hl == 0) { *(f32x4*)(rec + 4 + 4 * li) = a * f1 + a2 * f2; if (li == 0) { rec[0] = M; rec[1] = l * f1 + l2 * f2; } }
}
__device__ __forceinline__ void sample_attn_task(Frame& F, int task) {
    const int half = task & 1, t3 = task >> 1, br = t3 % 3, bh = t3 / 3, h = bh % 6, bs = bh / 6; const int dil = br == 0 ? 1 : (br == 1 ? 4 : 16);
    const f32x4 q4 = load_q_true((const bf16*)(F.ws + WS_QA) + (size_t)(MP + bs) * WA + h * 128, F.lane & 31);
    const size_t o1 = ((size_t)(bs * PASTW + PASTW - dil * (1 + 64 * half)) * 6 + h) * 128;
    decode_seq(q4, F.in[2] + o1, F.in[3] + o1, -(long)dil * WA, 32, F.lane, (float*)(F.ws + WS_SAMP + SAMP_AT) + (size_t)task * PSTR);
}
__device__ __forceinline__ void sample_mem_task(Frame& F, int task) {
    const int half = task & 1, bh = task >> 1, h = bh & 3, bs = bh >> 2;
    const f32x4 q4 = load_q_nat((const bf16*)(F.ws + WS_QM) + (size_t)(MP + bs) * WM + h * 128, F.lane & 31);
    const size_t o1 = ((size_t)(bs * NMEM + half * 128) * 4 + h) * 128;
    decode_seq(q4, F.in[5] + o1, F.in[6] + o1, 512, 64, F.lane, (float*)(F.ws + WS_SAMP + SAMP_ME) + (size_t)task * PSTR);
}
__device__ __forceinline__ void merge_prompt_attn(Frame& F) {
    const bf16* OP = (const bf16*)(F.ws + WS_OP); const float* LSE = (const float*)(F.ws + WS_LSE); const bf16* GA = (const bf16*)(F.ws + WS_GA); bf16* Z = (bf16*)(F.ws + WS_Z);
    const int gt = F.gw * 64 + F.lane, NTH = F.NGW * 64;
    for (int idx = gt; idx < MP * 96; idx += NTH) {
        const int r = idx / 96, c8 = idx % 96, h = c8 >> 4;
        const float l0 = LSE[(size_t)r * 6 + h], l1 = LSE[((size_t)MP + r) * 6 + h], l2 = LSE[((size_t)2 * MP + r) * 6 + h];
        const float M = fmaxf(l0, fmaxf(l1, l2)); float w0 = __builtin_amdgcn_exp2f(l0 - M), w1 = __builtin_amdgcn_exp2f(l1 - M), w2 = __builtin_amdgcn_exp2f(l2 - M);
        const float inv = 1.0f / (w0 + w1 + w2); w0 *= inv; w1 *= inv; w2 *= inv;
        const size_t off = (size_t)r * WA + c8 * 8;
        const v4u a = *(const v4u*)(OP + off), b = *(const v4u*)(OP + (size_t)MP * WA + off), c = *(const v4u*)(OP + (size_t)2 * MP * WA + off), g = *(const v4u*)(GA + off);
        v4u o;
        o.x = pk2((w0 * bflo(a.x) + w1 * bflo(b.x) + w2 * bflo(c.x)) * bflo(g.x), (w0 * bfhi(a.x) + w1 * bfhi(b.x) + w2 * bfhi(c.x)) * bfhi(g.x));
        o.y = pk2((w0 * bflo(a.y) + w1 * bflo(b.y) + w2 * bflo(c.y)) * bflo(g.y), (w0 * bfhi(a.y) + w1 * bfhi(b.y) + w2 * bfhi(c.y)) * bfhi(g.y));
        o.z = pk2((w0 * bflo(a.z) + w1 * bflo(b.z) + w2 * bflo(c.z)) * bflo(g.z), (w0 * bfhi(a.z) + w1 * bfhi(b.z) + w2 * bfhi(c.z)) * bfhi(g.z));
        o.w = pk2((w0 * bflo(a.w) + w1 * bflo(b.w) + w2 * bflo(c.w)) * bflo(g.w), (w0 * bfhi(a.w) + w1 * bfhi(b.w) + w2 * bfhi(c.w)) * bfhi(g.w));
        *(v4u*)(Z + (size_t)r * DM + c8 * 8) = o;
    }
}
__device__ __forceinline__ void merge_sample_task(Frame& F, int task) {
    const int lane = F.lane, li = lane & 31; const int bs = task / 10, hh = task % 10; const int r = MP + bs;
    bf16* Z = (bf16*)(F.ws + WS_Z);
    if (hh < 6) {
        const int h = hh;
        const f32x4 q4 = load_q_true((const bf16*)(F.ws + WS_QA) + (size_t)r * WA + h * 128, li);
        const f32x4 kn = *(const f32x4*)(F.out + OUT_KS + (size_t)bs * WA + h * 128 + 4 * li), vn = *(const f32x4*)(F.out + OUT_VS + (size_t)bs * WA + h * 128 + 4 * li);
        float sn = (q4[0] * kn[0] + q4[1] * kn[1]) + (q4[2] * kn[2] + q4[3] * kn[3]);
#pragma unroll
        for (int o = 1; o < 32; o <<= 1) sn += __shfl_xor(sn, o);
        const float* rec = (const float*)(F.ws + WS_SAMP + SAMP_AT) + (size_t)((bs * 6 + h) * 6) * PSTR;
        float M = sn;
#pragma unroll
        for (int i = 0; i < 6; ++i) M = fmaxf(M, rec[i * PSTR]);
        const float fn = 3.0f * __builtin_amdgcn_exp2f(sn - M);
        float L = fn; f32x4 a = vn * fn;
#pragma unroll
        for (int i = 0; i < 6; ++i) { const float f = __builtin_amdgcn_exp2f(rec[i * PSTR] - M); L += rec[i * PSTR + 1] * f; a += *(const f32x4*)(rec + i * PSTR + 4 + 4 * li) * f; }
        const float il = 1.0f / L; const u32x2 g = *(const u32x2*)((const bf16*)(F.ws + WS_GA) + (size_t)r * WA + h * 128 + 4 * li);
        if (lane < 32) { u32x2 o; o.x = pk2(a[0] * il * bflo(g.x), a[1] * il * bfhi(g.x)); o.y = pk2(a[2] * il * bflo(g.y), a[3] * il * bfhi(g.y)); *(u32x2*)(Z + (size_t)r * DM + h * 128 + 4 * li) = o; }
    } else {
        const int h = hh - 6;
        const float* rec = (const float*)(F.ws + WS_SAMP + SAMP_ME) + (size_t)((bs * 4 + h) * 2) * PSTR;
        const float m0 = rec[0], m1 = rec[PSTR]; const float M = fmaxf(m0, m1); const float f0 = __builtin_amdgcn_exp2f(m0 - M), f1 = __builtin_amdgcn_exp2f(m1 - M);
        const float L = rec[1] * f0 + rec[PSTR + 1] * f1;
        const f32x4 a = *(const f32x4*)(rec + 4 + 4 * li) * f0 + *(const f32x4*)(rec + PSTR + 4 + 4 * li) * f1;
        const float il = 1.0f / L; const u32x2 g = *(const u32x2*)((const bf16*)(F.ws + WS_GM) + (size_t)r * WM + h * 128 + 4 * li);
        if (lane < 32) { u32x2 o; o.x = pk2(a[0] * il * bflo(g.x), a[1] * il * bfhi(g.x)); o.y = pk2(a[2] * il * bflo(g.y), a[3] * il * bfhi(g.y)); *(u32x2*)(Z + (size_t)r * DM + 1536 + h * 128 + 4 * li) = o; }
    }
}

__global__ void __launch_bounds__(NWAVES * 64, 2) fwd_kernel(Args args) {
    extern __shared__ __attribute__((aligned(16))) unsigned char lds[];
    Frame F;
    F.lds = (LAS unsigned char*)lds;
    F.tid = threadIdx.x; F.lane = F.tid & 63; F.wave = __builtin_amdgcn_readfirstlane(F.tid >> 6);
    F.G = gridDim.x; { const int bx = blockIdx.x; F.vcu = (F.G % 8 == 0) ? (bx % 8) * (F.G / 8) + bx / 8 : bx; }
    F.gw = F.vcu * NWAVES + F.wave; F.NGW = F.G * NWAVES;
    F.ws = args.ws; F.out = args.out;
#pragma unroll
    for (int i = 0; i < 15; ++i) F.in[i] = args.in[i];
    gu32* ctl = (gu32*)(F.ws + WS_CTL);
    volatile LAS unsigned* MISC = (volatile LAS unsigned*)(F.lds + MISC_OFF);
    for (int u = F.tid; u < (LDS_BYTES - LDSCTL_OFF) / 4; u += NWAVES * 64) ((LAS unsigned*)(F.lds + LDSCTL_OFF))[u] = 0u;
    __syncthreads();
    XcdBarrier bar = xcd_barrier_post((unsigned*)(ctl + CW_BAR), MISC + 8);

    for (int rep = 0; rep < REP0; ++rep)
    p0_prologue(F);
    xcd_barrier(bar);
    for (int rep = 0; rep < REP1; ++rep)
    {
        pg8::Gemm g{(const pg8::bf16_t*)(F.ws + WS_XB), (const pg8::bf16_t*)(F.ws + WS_WT), MPAD + MMEM, NPROJ + 1024, DM};
        pg8::SchedProj S{F.G, (int)blockIdx.x};
        pg8::EpiProj E{F.ws, F.out};
        pg8::gemm_phase<pg8::EpiProj, pg8::SchedProj, true, true>(F.lds + RING_OFF, g, S, E);
    }
    xcd_barrier(bar);
    for (int rep = 0; rep < REP2; ++rep)
    {
        constexpr int N_HS = MS * 6 * 8, N_SA = MS * 6 * 3 * 2, N_SM = MS * 4 * 2;
        for (int it = F.gw; it < N_HS + N_SA + N_SM; it += F.NGW) {
            int r = it;
            if (r < N_HS) { hgrn_sample_item(F, r); continue; } r -= N_HS;
            if (r < N_SA) { sample_attn_task(F, r); continue; } r -= N_SA;
            sample_mem_task(F, r);
        }
        __syncthreads();
#if REP2A > 1
        for (int it = F.gw; it < N_HS + N_SA + N_SM; it += F.NGW) {
            int r = it;
            if (r < N_HS) { hgrn_sample_item(F, r); continue; } r -= N_HS;
            if (r < N_SA) { sample_attn_task(F, r); continue; } r -= N_SA;
            sample_mem_task(F, r);
        }
        __syncthreads();
#endif
        for (int rr = 0; rr < REP2B; ++rr) for (int u = F.vcu; u < 256; u += F.G) attn_unit_dispatch(F, u);
        for (int rr = 0; rr < REP2C; ++rr) for (int u = 256 + F.vcu; u < 1408; u += F.G) attn_unit_dispatch(F, u);
        for (int rr = 0; rr < REP2D; ++rr) for (int u = F.vcu; u < 768; u += F.G) hgrn_stage1_unit(F, u);
    }
    xcd_barrier(bar);
    for (int rep = 0; rep < REP3; ++rep) {
    for (int it = F.gw; it < 768; it += F.NGW) hgrn_scan_task(F, it);
    for (int it = F.gw; it < MS * 6; it += F.NGW) hgrn_norm_task(F, MP * 6 + it);
    merge_prompt_attn(F);
    for (int it = F.gw; it < MS * 10; it += F.NGW) merge_sample_task(F, it);
    }
    xcd_barrier(bar);
    for (int rep = 0; rep < REP3B; ++rep)
    for (int u = F.vcu; u < 768; u += F.G) hgrn_stage3_unit(F, u);
    xcd_barrier(bar);
    for (int rep = 1; rep < REP4A; ++rep) sample_outproj(F);
    for (int rep = 0; rep < REP4; ++rep)
    {
        if (rep == 0) sample_outproj(F);
        pg8::Gemm g{(const pg8::bf16_t*)(F.ws + WS_Z), (const pg8::bf16_t*)(F.ws + WS_WOUTT), MP, DM, DM};
        pg8::StaticOrder S; S.init(MP, DM, F.G, (int)blockIdx.x);
        pg8::EpiRes E{F.in[0], F.out + OUT_Y};
        pg8::gemm_phase<pg8::EpiRes, pg8::StaticOrder, true, true>(F.lds + RING_OFF, g, S, E);
    }
    xcd_barrier(bar);
    for (int m = F.gw; m < MTOK; m += F.NGW) {
        if (m < MP) ln_row(F, F.out + OUT_Y + (size_t)m * DM, F.out + OUT_Y + (size_t)m * DM);
        else ln_row(F, (const float*)(F.ws + WS_RS) + (size_t)(m - MP) * DM, F.out + OUT_YS + (size_t)(m - MP) * DM);
    }
}

extern "C" void kernel_launch(void* const* d_in, const int* in_sizes, int n_in, void* d_out, int out_size, void* d_ws, size_t ws_size, hipStream_t stream) {
    static int grid = 0;
    if (grid == 0) {
        if (n_in != 15 || out_size != (int)OUT_TOTAL || ws_size < WS_END) { fprintf(stderr, "kernel_launch: unexpected shapes (n_in %d out %d ws %zu)\n", n_in, out_size, ws_size); grid = -1; return; }
        int dev = 0, cus = 0, per_cu = 0;
        if (hipGetDevice(&dev) != hipSuccess || hipDeviceGetAttribute(&cus, hipDeviceAttributeMultiprocessorCount, dev) != hipSuccess) { grid = -1; return; }
        if (hipFuncSetAttribute((const void*)fwd_kernel, hipFuncAttributeMaxDynamicSharedMemorySize, LDS_BYTES) != hipSuccess) { fprintf(stderr, "kernel_launch: hipFuncSetAttribute failed\n"); grid = -1; return; }
        if (hipOccupancyMaxActiveBlocksPerMultiprocessor(&per_cu, (const void*)fwd_kernel, NWAVES * 64, LDS_BYTES) != hipSuccess || per_cu < 1) { fprintf(stderr, "kernel_launch: occupancy query says %d blocks per CU\n", per_cu); per_cu = 1; }
        (void)hipGetLastError();
        grid = cus;
    }
    if (grid < 0) return;
    if (hipMemsetAsync((char*)d_ws + WS_CTL, 0, CTL_ZERO_BYTES, stream) != hipSuccess) { fprintf(stderr, "kernel_launch: memset failed\n"); return; }
    Args a{};
    for (int i = 0; i < 15; ++i) a.in[i] = (const float*)d_in[i];
    a.out = (float*)d_out; a.ws = (unsigned char*)d_ws;
    hipLaunchKernelGGL(fwd_kernel, dim3(grid), dim3(NWAVES * 64), LDS_BYTES, stream, a);
}
```
